# Optimizing an MI355X kernel written in HIP

```python
import math
import jax, jax.numpy as jnp
from jax import lax
import numpy as np

D_MODEL = 1024
BATCH = 16
SEQ = 4096
DEPTH = 4
DEC_BATCH = 8
DEC_SEQ = 2048
PAST_LEN = 128

N_MIXERS = 2
N_ATTN_LAYERS = (DEPTH + 1) // 2
N_CONV_LAYERS = DEPTH // 2
HEAD_DIM = 64
N_HEADS = D_MODEL // HEAD_DIM
N_KV_HEADS = N_HEADS // 4
Q_PER_KV = N_HEADS // N_KV_HEADS
WINDOW = 128
BLOCK = 128
N_BUCKETS = 32
MAX_DISTANCE = 128
CONV_WIDTH = 3
D_FF = 4 * D_MODEL
PLE_DIM = 256
EPS = 1e-6
NEG_INF = -1e30

kernel_name = "hybrid_swa_shortconv_encoder"


def rms_norm(x, g):
    xf = x.astype(jnp.float32)
    y = xf * lax.rsqrt(jnp.mean(xf * xf, axis=-1, keepdims=True) + EPS)
    return (y * g.astype(jnp.float32)).astype(x.dtype)


def t5_bucket(rel):
    half = N_BUCKETS // 2
    max_exact = half // 2
    ret = jnp.where(rel > 0, half, 0)
    n = jnp.abs(rel)
    nf = jnp.maximum(n, 1).astype(jnp.float32)
    large = max_exact + (jnp.log(nf / max_exact) / math.log(MAX_DISTANCE / max_exact)
                         * (half - max_exact)).astype(jnp.int32)
    large = jnp.minimum(large, half - 1)
    return ret + jnp.where(n < max_exact, n, large)


def band_geometry(rel_bias):
    rel = (jnp.arange(3 * BLOCK)[None, :] - BLOCK) - jnp.arange(BLOCK)[:, None]
    in_window = jnp.abs(rel) <= WINDOW
    bias = rel_bias[t5_bucket(rel)].astype(jnp.float32)
    bias = jnp.transpose(bias, (2, 0, 1)).reshape(N_KV_HEADS, Q_PER_KV, BLOCK, 3 * BLOCK)
    return bias, in_window


def window_attention(h, w_qkv, w_o, sink, band_bias, in_window):
    b, s, _ = h.shape
    nb = s // BLOCK
    qkv = h @ w_qkv
    nq = N_HEADS * HEAD_DIM
    nk = N_KV_HEADS * HEAD_DIM
    q = qkv[..., :nq].reshape(b, nb, BLOCK, N_KV_HEADS, Q_PER_KV, HEAD_DIM)
    k = qkv[..., nq:nq + nk].reshape(b, s, N_KV_HEADS, HEAD_DIM)
    v = qkv[..., nq + nk:].reshape(b, s, N_KV_HEADS, HEAD_DIM)
    pad = ((0, 0), (BLOCK, BLOCK), (0, 0), (0, 0))
    kp = jnp.pad(k, pad)
    vp = jnp.pad(v, pad)
    sink_logit = sink.astype(jnp.float32).reshape(1, N_KV_HEADS, Q_PER_KV, 1, 1)
    scale = HEAD_DIM ** -0.5

    def block_fn(n):
        qb = lax.dynamic_index_in_dim(q, n, axis=1, keepdims=False)
        kb = lax.dynamic_slice_in_dim(kp, n * BLOCK, 3 * BLOCK, axis=1)
        vb = lax.dynamic_slice_in_dim(vp, n * BLOCK, 3 * BLOCK, axis=1)
        key_pos = n * BLOCK - BLOCK + jnp.arange(3 * BLOCK)
        valid = in_window & ((key_pos >= 0) & (key_pos < s))[None, :]
        logits = jnp.einsum('bqgrd,bkgd->bgrqk', qb, kb,
                            preferred_element_type=jnp.float32) * scale + band_bias
        logits = jnp.where(valid, logits, NEG_INF)
        m = jnp.maximum(jnp.max(logits, axis=-1, keepdims=True), sink_logit)
        pexp = jnp.exp(logits - m)
        denom = jnp.sum(pexp, axis=-1, keepdims=True) + jnp.exp(sink_logit - m)
        probs = (pexp / denom).astype(vb.dtype)
        return jnp.einsum('bgrqk,bkgd->bqgrd', probs, vb)

    out = lax.map(block_fn, jnp.arange(nb))
    out = jnp.moveaxis(out, 0, 1).reshape(b, s, nq)
    return out @ w_o


def short_conv(h, w_in, conv_w, w_out):
    s = h.shape[1]
    b_gate, c_gate, u = jnp.split(h @ w_in, 3, axis=-1)
    z = c_gate * u
    half = CONV_WIDTH // 2
    zp = jnp.pad(z, ((0, 0), (half, half), (0, 0)))
    conv = zp[:, 0:s] * conv_w[0]
    for t in range(1, CONV_WIDTH):
        conv = conv + zp[:, t:t + s] * conv_w[t]
    return (b_gate * conv) @ w_out


def trunk(x, p, rel_bias, attn_w_qkv, attn_w_o, attn_sink, conv_w_in, conv_w, conv_w_out,
          mlp_w_up, mlp_w_down, ple_w_gate, ple_w_proj, norm_mix, norm_mlp, norm_ple, final_norm):
    band_bias, in_window = band_geometry(rel_bias)
    for i in range(DEPTH):
        j = i // N_MIXERS
        h = rms_norm(x, norm_mix[i])
        if i % N_MIXERS == 0:
            x = x + window_attention(h, attn_w_qkv[j], attn_w_o[j], attn_sink[j], band_bias, in_window)
        else:
            x = x + short_conv(h, conv_w_in[j], conv_w[j], conv_w_out[j])
        h = rms_norm(x, norm_mlp[i])
        x = x + jnp.square(jax.nn.relu(h @ mlp_w_up[i])) @ mlp_w_down[i]
        gate = jax.nn.sigmoid(rms_norm(x, norm_ple[i]) @ ple_w_gate[i])
        x = x + (p[i] @ ple_w_proj[i]) * gate
    return rms_norm(x, final_norm)


def setup_inputs(seed: int = 0) -> dict:
    key = jax.random.key(seed)
    ks = jax.random.split(key, 20)
    f32 = jnp.float32
    D = D_MODEL
    qkv_w = (N_HEADS + 2 * N_KV_HEADS) * HEAD_DIM

    def nrm(k, shape, scale):
        return jax.random.normal(k, shape, f32) * scale

    return {
        "x_prompt": nrm(ks[0], (BATCH, SEQ, D), 1.0),
        "x_sample": nrm(ks[1], (DEC_BATCH, DEC_SEQ, D), 1.0),
        "p_prompt": nrm(ks[2], (DEPTH, BATCH, SEQ, PLE_DIM), 1.0),
        "p_sample": nrm(ks[3], (DEPTH, DEC_BATCH, DEC_SEQ, PLE_DIM), 1.0),
        "rel_bias": nrm(ks[4], (N_BUCKETS, N_HEADS), 0.3),
        "attn_w_qkv": nrm(ks[5], (N_ATTN_LAYERS, D, qkv_w), D ** -0.5),
        "attn_w_o": nrm(ks[6], (N_ATTN_LAYERS, N_HEADS * HEAD_DIM, D), (N_HEADS * HEAD_DIM) ** -0.5),
        "attn_sink": nrm(ks[7], (N_ATTN_LAYERS, N_HEADS), 0.5),
        "conv_w_in": nrm(ks[8], (N_CONV_LAYERS, D, 3 * D), D ** -0.5),
        "conv_w": nrm(ks[9], (N_CONV_LAYERS, CONV_WIDTH, D), CONV_WIDTH ** -0.5),
        "conv_w_out": nrm(ks[10], (N_CONV_LAYERS, D, D), D ** -0.5),
        "mlp_w_up": nrm(ks[11], (DEPTH, D, D_FF), D ** -0.5),
        "mlp_w_down": nrm(ks[12], (DEPTH, D_FF, D), D_FF ** -0.5),
        "ple_w_gate": nrm(ks[13], (DEPTH, D, D), D ** -0.5),
        "ple_w_proj": nrm(ks[14], (DEPTH, PLE_DIM, D), PLE_DIM ** -0.5),
        "norm_mix": 1.0 + nrm(ks[15], (DEPTH, D), 0.05),
        "norm_mlp": 1.0 + nrm(ks[16], (DEPTH, D), 0.05),
        "norm_ple": 1.0 + nrm(ks[17], (DEPTH, D), 0.05),
        "final_norm": 1.0 + nrm(ks[18], (D,), 0.05),
    }


def reference(x_prompt, x_sample, p_prompt, p_sample, rel_bias, attn_w_qkv, attn_w_o, attn_sink,
              conv_w_in, conv_w, conv_w_out, mlp_w_up, mlp_w_down, ple_w_gate, ple_w_proj,
              norm_mix, norm_mlp, norm_ple, final_norm):
    y_prompt = trunk(x_prompt, p_prompt, rel_bias, attn_w_qkv, attn_w_o, attn_sink, conv_w_in, conv_w,
                     conv_w_out, mlp_w_up, mlp_w_down, ple_w_gate, ple_w_proj,
                     norm_mix, norm_mlp, norm_ple, final_norm)
    y_sample = trunk(x_sample, p_sample, rel_bias, attn_w_qkv, attn_w_o, attn_sink, conv_w_in, conv_w,
                     conv_w_out, mlp_w_up, mlp_w_down, ple_w_gate, ple_w_proj,
                     norm_mix, norm_mlp, norm_ple, final_norm)
    return (y_prompt, y_sample)
```

```cpp
#include <hip/hip_runtime.h>
#include <hip/hip_cooperative_groups.h>
#include <cstdio>
#include <cstdint>
namespace cg = cooperative_groups;
namespace pg8 {
#define PG8_LAS __attribute__((address_space(3)))
typedef unsigned short bf16_t;
typedef short bf16x8 __attribute__((ext_vector_type(8)));
typedef float f32x4 __attribute__((ext_vector_type(4)));
typedef unsigned u32x4 __attribute__((ext_vector_type(4)));
constexpr int BM = 256, BK = 64, HALF = 128, HTB = HALF * BK * 2  , STAGE_BYTES = 8 * HTB, NXCD = 8, WGM = 8;

__host__ __device__ __forceinline__ int lds_byte(int r, int c) { const int st = (r >> 4) * 2 + (c >> 5), rr = r & 15, cc = c & 31, ob = rr * 64 + cc * 2; return st * 1024 + (ob ^ (((ob >> 9) & 1) << 5)); }
__host__ __device__ __forceinline__ void stage_rc(int b, int& R, int& C) { const int st = b / 1024, sb = b % 1024, swz = sb ^ (((sb >> 9) & 1) << 5); R = (st >> 1) * 16 + swz / 64; C = (st & 1) * 32 + (swz % 64) / 2; }
__host__ __device__ __forceinline__ int perm32(int rho) { const int n = rho >> 4, i = rho & 15; return 8 * (i >> 2) + 4 * n + (i & 3); }

struct Unit { int pm, pn; };
struct Gemm { const bf16_t* A; const bf16_t* Bt; int M, N, K; };

struct StaticOrder {
    int nM, nN, nwg, G, c;
    __host__ __device__ void init(int M, int N, int G_, int c_) { nM = M / BM; nN = N / BM; nwg = nM * nN; G = G_; c = c_; }
    __host__ __device__ bool next(int i, Unit& u) const {
        const long L = (long)i * G + c; if (L >= nwg) return false;
        int wgid = (int)L; { const int q = nwg / NXCD, r = nwg % NXCD, xcd = wgid % NXCD, off = wgid / NXCD; wgid = (xcd < r ? xcd * (q + 1) : r * (q + 1) + (xcd - r) * q) + off; }
        const int nig = WGM * nN, gid = wgid / nig, fm = gid * WGM, gsz = (nM - fm) < WGM ? (nM - fm) : WGM;
        u.pm = fm + ((wgid % nig) % gsz); u.pn = (wgid % nig) / gsz; return true;
    }
    __device__ __forceinline__ void a_ready(const Unit&) const {}
    __device__ __forceinline__ void done(const Unit&) const {}
};

__device__ __forceinline__ unsigned cvt_pk_bf16(float lo, float hi) { unsigned r; asm volatile("v_cvt_pk_bf16_f32 %0, %1, %2" : "=v"(r) : "v"(lo), "v"(hi)); return r; }
typedef float f32x2 __attribute__((ext_vector_type(2)));
template <class Epi, class Sched, bool ALIGN_EPI = false, bool SP2 = false>
__device__ __forceinline__ void gemm_phase(PG8_LAS unsigned char* lds, const Gemm g, const Sched& S, const Epi& E) {
    int tid_ = threadIdx.x; asm volatile("" : "+v"(tid_));
    const int tid = tid_, wid = __builtin_amdgcn_readfirstlane(tid >> 6), lane = tid & 63, wr = wid >> 2, wc = wid & 3, fr = lane & 15, fq = lane >> 4;
    int K_ = g.K; asm volatile("" : "+s"(K_));
    const int K = K_, nt = K / BK;
    unsigned voffA[2], voffB[2];
#pragma unroll
    for (int i = 0; i < 2; ++i) { int R, C; stage_rc(tid * 16 + i * 8192, R, C); const int Rb = Epi::PERM ? ((R & ~31) + perm32(R & 31)) : R;
        voffA[i] = (unsigned)(R * K + C) * 2u; voffB[i] = (unsigned)(Rb * K + C) * 2u; }
    const size_t kstep = (size_t)(BK * 2);
    const size_t hstep = (size_t)HALF * K * 2;
    const size_t tstep = 2 * hstep;
    const unsigned ldsw = (unsigned)wid * 1024u;
    const int aoff = lds_byte(wr * 64 + fr, fq * 8), boff = lds_byte(wc * 32 + fr, fq * 8);
#define PG8_SA(b, h) (((b) * 2 + (h)) * HTB)
#define PG8_SB(b, h) ((4 + (b) * 2 + (h)) * HTB)
#define PG8_STAGE(bufoff, gbase, voff) do { _Pragma("unroll") for (int _i = 0; _i < 2; ++_i) \
        __builtin_amdgcn_global_load_lds((const unsigned*)((const char*)(gbase) + (voff)[_i]), (PG8_LAS unsigned*)(lds + (bufoff) + ldsw + _i * 8192), 16, 0, 0); } while (0)
#define PG8_LDA(dst, b, h) do { _Pragma("unroll") for (int m = 0; m < 4; ++m) _Pragma("unroll") for (int k = 0; k < 2; ++k) dst[m][k] = *(const PG8_LAS bf16x8*)(lds + PG8_SA(b, h) + aoff + m * 2048 + k * 1024); } while (0)
#define PG8_LDB(dst, b, h) do { _Pragma("unroll") for (int n = 0; n < 2; ++n) _Pragma("unroll") for (int k = 0; k < 2; ++k) dst[n][k] = *(const PG8_LAS bf16x8*)(lds + PG8_SB(b, h) + boff + n * 2048 + k * 1024); } while (0)
#define PG8_MMA(ai, bj, At, Bt) do { __builtin_amdgcn_s_setprio(1); _Pragma("unroll") for (int m = 0; m < 4; ++m) _Pragma("unroll") for (int n = 0; n < 2; ++n) _Pragma("unroll") for (int k = 0; k < 2; ++k) \
        acc[ai][bj][m][n] = __builtin_amdgcn_mfma_f32_16x16x32_bf16(Bt[n][k], At[m][k], acc[ai][bj][m][n], 0, 0, 0); __builtin_amdgcn_s_setprio(0); } while (0)
#define PG8_WAIT_V(n) asm volatile("s_waitcnt vmcnt(" #n ")" ::: "memory")
#define PG8_WAIT_L(n) asm volatile("s_waitcnt lgkmcnt(" #n ")" ::: "memory")
#define PG8_BAR __builtin_amdgcn_s_barrier()
#define PG8_SCHED __builtin_amdgcn_sched_barrier(0)
    Unit cur, nxt; int ui = 0;
    if (!S.next(0, cur)) return;
    f32x4 acc[2][2][4][2];
#pragma unroll
    for (int a = 0; a < 2; ++a)
#pragma unroll
        for (int b = 0; b < 2; ++b)
#pragma unroll
            for (int m = 0; m < 4; ++m)
#pragma unroll
                for (int n = 0; n < 2; ++n) acc[a][b][m][n] = (f32x4){0.f, 0.f, 0.f, 0.f};
    bf16x8 At[4][2], B0[2][2], B1[2][2];
    const char* cA = (const char*)g.A + (size_t)cur.pm * tstep; const char* cB = (const char*)g.Bt + (size_t)cur.pn * tstep;
    S.a_ready(cur);
    if constexpr (SP2) {
        PG8_STAGE(PG8_SB(0, 0), cB, voffB); PG8_STAGE(PG8_SB(0, 1), cB + hstep, voffB); PG8_STAGE(PG8_SA(0, 0), cA, voffA); PG8_STAGE(PG8_SA(0, 1), cA + hstep, voffA);
        if (wr == 1) PG8_BAR;
        PG8_WAIT_V(2); PG8_BAR;
        PG8_STAGE(PG8_SB(1, 0), cB + kstep, voffB); PG8_STAGE(PG8_SA(1, 0), cA + kstep, voffA); PG8_STAGE(PG8_SB(1, 1), cB + hstep + kstep, voffB);
        PG8_WAIT_V(6); PG8_BAR;
    } else {
        PG8_STAGE(PG8_SB(0, 0), cB, voffB); PG8_STAGE(PG8_SA(0, 0), cA, voffA); PG8_STAGE(PG8_SB(0, 1), cB + hstep, voffB); PG8_STAGE(PG8_SA(0, 1), cA + hstep, voffA);
        if (wr == 1) PG8_BAR;
        PG8_WAIT_V(4); PG8_BAR;
        PG8_STAGE(PG8_SB(1, 0), cB + kstep, voffB); PG8_STAGE(PG8_SA(1, 0), cA + kstep, voffA); PG8_STAGE(PG8_SB(1, 1), cB + hstep + kstep, voffB);
        PG8_WAIT_V(6); PG8_BAR;
    }
    for (;;) {
        const bool has_next = S.next(ui + 1, nxt);
        const char* nA = has_next ? (const char*)g.A + (size_t)nxt.pm * tstep : cA; const char* nB = has_next ? (const char*)g.Bt + (size_t)nxt.pn * tstep : cB;
        for (int t = 0; t < nt; t += 2) {
            const bool last = (t == nt - 2);
            const char* a1 = cA + (size_t)(t + 1) * kstep;
            const char* a2 = last ? nA : cA + (size_t)(t + 2) * kstep; const char* b2 = last ? nB : cB + (size_t)(t + 2) * kstep;
            const char* a3 = a2 + kstep; const char* b3 = b2 + kstep;
            if (last && has_next) S.a_ready(nxt);
            if constexpr (SP2) {
            PG8_LDB(B0, 0, 0); PG8_LDB(B1, 0, 1); PG8_SCHED; PG8_LDA(At, 0, 0); PG8_STAGE(PG8_SA(1, 1), a1 + hstep, voffA);
            PG8_WAIT_V(8); PG8_WAIT_L(0); PG8_BAR; PG8_MMA(0, 0, At, B0); PG8_MMA(0, 1, At, B1); PG8_BAR; PG8_SCHED;
            PG8_LDA(At, 0, 1); PG8_STAGE(PG8_SB(0, 0), b2, voffB); PG8_STAGE(PG8_SB(0, 1), b2 + hstep, voffB); PG8_STAGE(PG8_SA(0, 0), a2, voffA);
            PG8_WAIT_V(8); PG8_WAIT_L(0); PG8_BAR; PG8_MMA(1, 0, At, B0); PG8_MMA(1, 1, At, B1); PG8_BAR; PG8_SCHED;
            PG8_LDB(B0, 1, 0); PG8_LDB(B1, 1, 1); PG8_SCHED; PG8_LDA(At, 1, 0); PG8_STAGE(PG8_SA(0, 1), a2 + hstep, voffA);
            PG8_WAIT_V(8); PG8_WAIT_L(0); PG8_BAR; PG8_MMA(0, 0, At, B0); PG8_MMA(0, 1, At, B1); PG8_BAR; PG8_SCHED;
            PG8_LDA(At, 1, 1); PG8_STAGE(PG8_SB(1, 0), b3, voffB); PG8_STAGE(PG8_SB(1, 1), b3 + hstep, voffB); PG8_STAGE(PG8_SA(1, 0), a3, voffA);
            PG8_WAIT_V(8); PG8_WAIT_L(0); PG8_BAR; PG8_MMA(1, 0, At, B0); PG8_MMA(1, 1, At, B1); PG8_BAR; PG8_SCHED;
            } else {
            PG8_LDB(B0, 0, 0); PG8_SCHED; PG8_LDA(At, 0, 0); PG8_STAGE(PG8_SA(1, 1), a1 + hstep, voffA);
            PG8_WAIT_L(8); PG8_BAR; PG8_WAIT_L(0); PG8_MMA(0, 0, At, B0); PG8_BAR; PG8_SCHED;
            PG8_LDB(B1, 0, 1); PG8_STAGE(PG8_SB(0, 0), b2, voffB);
            PG8_BAR; PG8_WAIT_L(0); PG8_MMA(0, 1, At, B1); PG8_BAR;
            PG8_LDA(At, 0, 1); PG8_STAGE(PG8_SA(0, 0), a2, voffA);
            PG8_BAR; PG8_WAIT_L(0); PG8_MMA(1, 0, At, B0); PG8_BAR; PG8_SCHED;
            PG8_STAGE(PG8_SB(0, 1), b2 + hstep, voffB);
            PG8_WAIT_V(6); PG8_BAR; PG8_MMA(1, 1, At, B1); PG8_BAR;
            PG8_LDB(B0, 1, 0); PG8_SCHED; PG8_LDA(At, 1, 0); PG8_STAGE(PG8_SA(0, 1), a2 + hstep, voffA);
            PG8_WAIT_L(8); PG8_BAR; PG8_WAIT_L(0); PG8_MMA(0, 0, At, B0); PG8_BAR; PG8_SCHED;
            PG8_LDB(B1, 1, 1); PG8_STAGE(PG8_SB(1, 0), b3, voffB);
            PG8_BAR; PG8_WAIT_L(0); PG8_MMA(0, 1, At, B1); PG8_BAR;
            PG8_LDA(At, 1, 1); PG8_STAGE(PG8_SA(1, 0), a3, voffA);
            PG8_BAR; PG8_WAIT_L(0); PG8_MMA(1, 0, At, B0); PG8_BAR; PG8_SCHED;
            PG8_STAGE(PG8_SB(1, 1), b3 + hstep, voffB);
            PG8_WAIT_V(6); PG8_BAR; PG8_MMA(1, 1, At, B1); PG8_BAR;
            }
        }
        if constexpr (ALIGN_EPI) { if (wr == 0) PG8_BAR; }
        if constexpr (!Epi::AFTER_DRAIN) { E(acc, cur, wr, wc, fr, fq); S.done(cur); }
        if (!has_next) break;
#pragma unroll
        for (int a = 0; a < 2; ++a)
#pragma unroll
            for (int b = 0; b < 2; ++b)
#pragma unroll
                for (int m = 0; m < 4; ++m)
#pragma unroll
                    for (int n = 0; n < 2; ++n) acc[a][b][m][n] = (f32x4){0.f, 0.f, 0.f, 0.f};
        cur = nxt; cA = nA; cB = nB; ++ui;
        if constexpr (ALIGN_EPI) { if (wr == 1) PG8_BAR; }
    }
    PG8_WAIT_V(0);
    if constexpr (!ALIGN_EPI) { if (wr == 0) PG8_BAR; }
    PG8_BAR;
    if constexpr (Epi::AFTER_DRAIN) { E.fused(acc, cur, wr, wc, fr, fq, lds, wid, lane); S.done(cur); }
#undef PG8_SA
#undef PG8_SB
#undef PG8_STAGE
#undef PG8_LDA
#undef PG8_LDB
#undef PG8_MMA
#undef PG8_WAIT_V
#undef PG8_WAIT_L
#undef PG8_BAR
#undef PG8_SCHED
}
}
namespace pg8 {
constexpr float QSCALE = 0.125f * 1.4426950408889634f;
constexpr float RMS_EPS = 1e-6f;
constexpr int MP_ROWS = 65536;
__device__ __forceinline__ float ss_sum(const float* ss, int row) { const f32x4* p = (const f32x4*)(ss + (size_t)row * 16); const f32x4 a = p[0], b = p[1], c = p[2], d = p[3];
    return (((a[0] + a[1]) + (a[2] + a[3])) + ((b[0] + b[1]) + (b[2] + b[3]))) + (((c[0] + c[1]) + (c[2] + c[3])) + ((d[0] + d[1]) + (d[2] + d[3]))); }
__device__ __forceinline__ float rinv_of(const float* ss, int row) { return __builtin_amdgcn_rsqf(ss_sum(ss, row) * (1.0f / 1024.0f) + RMS_EPS); }
__device__ __forceinline__ float bf_lo(unsigned w) { return __uint_as_float(w << 16); }
__device__ __forceinline__ float bf_hi(unsigned w) { return __uint_as_float(w & 0xffff0000u); }

template <int MODE> struct EpiBf16R {
    static constexpr bool PERM = true, AFTER_DRAIN = false;
    bf16_t* O; int ldc; const float* ss;
    __device__ __forceinline__ void operator()(const f32x4 (&acc)[2][2][4][2], const Unit& u, int wr, int wc, int fr, int fq) const {
        const int row0 = u.pm * BM + wr * 64 + fr;
        const int colw = wc * 32 + 8 * fq;
        float sc = 1.f;
        if (MODE == 1) { if (u.pn < 4) sc = QSCALE; }
#pragma unroll
        for (int ai = 0; ai < 2; ++ai)
#pragma unroll
            for (int m = 0; m < 4; ++m) {
                const int row = row0 + ai * HALF + m * 16;
                float rs = sc;
                if (MODE != 0) rs *= rinv_of(ss, row);
                bf16_t* rowp = O + (size_t)row * ldc;
                if (MODE == 3 && u.pn >= 4) {
                    const f32x4 z0 = (acc[ai][0][m][0] * rs) * (acc[ai][1][m][0] * rs), z1 = (acc[ai][0][m][1] * rs) * (acc[ai][1][m][1] * rs);
                    u32x4 w; w.x = cvt_pk_bf16(z0[0], z0[1]); w.y = cvt_pk_bf16(z0[2], z0[3]); w.z = cvt_pk_bf16(z1[0], z1[1]); w.w = cvt_pk_bf16(z1[2], z1[3]);
                    *(u32x4*)(rowp + 1024 + (u.pn - 4) * HALF + colw) = w;
                } else {
#pragma unroll
                    for (int bj = 0; bj < 2; ++bj) {
                        f32x4 v0 = acc[ai][bj][m][0] * rs, v1 = acc[ai][bj][m][1] * rs;
                        if (MODE == 2) {
#pragma unroll
                            for (int e = 0; e < 4; ++e) { const float a = fmaxf(v0[e], 0.f), b = fmaxf(v1[e], 0.f); v0[e] = a * a; v1[e] = b * b; }
                        }
                        u32x4 w; w.x = cvt_pk_bf16(v0[0], v0[1]); w.y = cvt_pk_bf16(v0[2], v0[3]); w.z = cvt_pk_bf16(v1[0], v1[1]); w.w = cvt_pk_bf16(v1[2], v1[3]);
                        *(u32x4*)(rowp + u.pn * BM + bj * HALF + colw) = w;
                    }
                }
            }
    }
};

template <int MODE> struct EpiResid {
    static constexpr bool PERM = true, AFTER_DRAIN = false;
    const float* xsrc_p; const float* xsrc_s; float* xdst; bf16_t* xb; float* ss_next; const float* ss_cur; const bf16_t* T;
    __device__ __forceinline__ void operator()(const f32x4 (&acc)[2][2][4][2], const Unit& u, int wr, int wc, int fr, int fq) const {
        const int row0 = u.pm * BM + wr * 64 + fr;
        const int col0 = u.pn * BM + wc * 32 + 8 * fq;
        const float* xs = (u.pm < MP_ROWS / BM) ? xsrc_p : (xsrc_s - (size_t)MP_ROWS * 1024);
#pragma unroll
        for (int ai = 0; ai < 2; ++ai)
#pragma unroll
            for (int m = 0; m < 4; ++m) {
                const int row = row0 + ai * HALF + m * 16;
                const size_t roff = (size_t)row * 1024 + col0;
                float rs = 0.f;
                if (MODE == 1) rs = rinv_of(ss_cur, row) * (-1.4426950408889634f);
                float sq = 0.f;
#pragma unroll
                for (int bj = 0; bj < 2; ++bj) {
                    const f32x4 o0 = *(const f32x4*)(xs + roff + bj * HALF), o1 = *(const f32x4*)(xs + roff + bj * HALF + 4);
                    f32x4 d0 = acc[ai][bj][m][0], d1 = acc[ai][bj][m][1];
                    if (MODE == 1) {
                        const u32x4 t = *(const u32x4*)(T + roff + bj * HALF);
                        f32x4 t0, t1; t0[0] = bf_lo(t.x); t0[1] = bf_hi(t.x); t0[2] = bf_lo(t.y); t0[3] = bf_hi(t.y); t1[0] = bf_lo(t.z); t1[1] = bf_hi(t.z); t1[2] = bf_lo(t.w); t1[3] = bf_hi(t.w);
#pragma unroll
                        for (int e = 0; e < 4; ++e) {
                            d0[e] = t0[e] * __builtin_amdgcn_rcpf(1.0f + __builtin_amdgcn_exp2f(d0[e] * rs));
                            d1[e] = t1[e] * __builtin_amdgcn_rcpf(1.0f + __builtin_amdgcn_exp2f(d1[e] * rs));
                        }
                    }
                    const f32x4 x0 = o0 + d0, x1 = o1 + d1;
                    *(f32x4*)(xdst + roff + bj * HALF) = x0; *(f32x4*)(xdst + roff + bj * HALF + 4) = x1;
                    u32x4 w; w.x = cvt_pk_bf16(x0[0], x0[1]); w.y = cvt_pk_bf16(x0[2], x0[3]); w.z = cvt_pk_bf16(x1[0], x1[1]); w.w = cvt_pk_bf16(x1[2], x1[3]);
                    *(u32x4*)(xb + roff + bj * HALF) = w;
                    sq += (x0[0] * x0[0] + x0[1] * x0[1]) + (x0[2] * x0[2] + x0[3] * x0[3]) + (x1[0] * x1[0] + x1[1] * x1[1]) + (x1[2] * x1[2] + x1[3] * x1[3]);
                }
                sq += __shfl_xor(sq, 16); sq += __shfl_xor(sq, 32);
                if (fq == 0) ss_next[(size_t)row * 16 + u.pn * 4 + wc] = sq;
            }
    }
};
}
namespace attn {
#define ALAS __attribute__((address_space(3)))
typedef unsigned short bf16_t;
typedef short bf16x8 __attribute__((ext_vector_type(8)));
typedef short s16x4 __attribute__((ext_vector_type(4)));
typedef short v4i16_t __attribute__((ext_vector_type(4)));
typedef float f32x16 __attribute__((ext_vector_type(16)));
typedef unsigned u32x4 __attribute__((ext_vector_type(4)));
typedef unsigned u32x2 __attribute__((ext_vector_type(2)));
constexpr int QKV_LD = 1536, KOFF = 1024, VOFF = 1280, O_LD = 1024;
constexpr int LDS_K = 0, LDS_V = 49152, LDS_BT = 98304, BT_STRIDE = 320, LDS_BYTES = LDS_BT + 4 * BT_STRIDE * 4;
constexpr int BIAS_LD = 320;
__device__ __forceinline__ int crow(int r, int hi) { return (r & 3) + 8 * (r >> 2) + 4 * hi; }
__device__ __forceinline__ unsigned cvtpk(float lo, float hi) { unsigned r; asm volatile("v_cvt_pk_bf16_f32 %0, %1, %2" : "=v"(r) : "v"(lo), "v"(hi)); return r; }

__device__ __forceinline__ void attn_unit(ALAS unsigned char* lds, const bf16_t* __restrict__ QKV, bf16_t* __restrict__ O, const float* __restrict__ biasg, const float* __restrict__ sink2,
                                          int rowbase, int q0, int S, int g) {
    int tid_ = threadIdx.x; asm volatile("" : "+v"(tid_));
    const int tid = tid_, lane = tid & 63, ql = lane & 31, hi = lane >> 5;
    const int wid = __builtin_amdgcn_readfirstlane(tid >> 6);
    const int r4 = wid >> 1, qh = wid & 1, h = g * 4 + r4;
#pragma unroll
    for (int i = 0; i < 6; ++i) {
        const int chunk = tid + 512 * i, kvr = chunk >> 3, c = chunk & 7, pos = q0 - 128 + kvr;
        u32x4 kk = (u32x4){0u, 0u, 0u, 0u}, vv = (u32x4){0u, 0u, 0u, 0u};
        if (pos >= 0 && pos < S) {
            const bf16_t* src = QKV + (size_t)(rowbase + pos) * QKV_LD + g * 64 + c * 8;
            kk = *(const u32x4*)(src + KOFF); vv = *(const u32x4*)(src + VOFF);
        }
        *(ALAS u32x4*)(lds + LDS_K + kvr * 128 + ((c ^ ((kvr >> 1) & 7)) * 16)) = kk;
        *(ALAS u32x4*)(lds + LDS_V + (c >> 2) * 24576 + (kvr >> 3) * 512 + (kvr & 7) * 64 + (c & 3) * 16) = vv;
    }
    for (int i = tid; i < 4 * BT_STRIDE; i += 512) ((ALAS float*)(lds + LDS_BT))[i] = biasg[(g * 4) * BIAS_LD + i];
    const int R0 = rowbase + q0 + qh * 64;
    bf16x8 qr[2][4];
#pragma unroll
    for (int qt = 0; qt < 2; ++qt)
#pragma unroll
        for (int ds = 0; ds < 4; ++ds) qr[qt][ds] = *(const bf16x8*)(QKV + (size_t)(R0 + qt * 32 + ql) * QKV_LD + h * 64 + ds * 16 + hi * 8);
    const float snk = sink2[h];
    __syncthreads();
    const ALAS unsigned char* kbase = lds + LDS_K;
    const ALAS float* bt = (const ALAS float*)(lds + LDS_BT) + r4 * BT_STRIDE;
    const int ktlo = (q0 == 0) ? 4 : 0, kthi = (q0 + 128 >= S) ? 7 : 11;
    const int vlane = (4 * hi + ((lane & 15) >> 2)) * 64 + ((lane >> 4) & 1) * 32 + (lane & 3) * 8;
#pragma unroll
    for (int qt = 0; qt < 2; ++qt) {
        const int ot = qh * 2 + qt;
        int k0 = ot, k1 = ot + 8; if (k0 < ktlo) k0 = ktlo; if (k1 > kthi) k1 = kthi;
        float mrun = snk, lrun = (hi == 0) ? 1.0f : 0.0f;
        f32x16 o0, o1;
#pragma unroll
        for (int r = 0; r < 16; ++r) { o0[r] = 0.f; o1[r] = 0.f; }
        for (int kt = k0; kt <= k1; ++kt) {
            const int ktp = kt - ot;
            const int kvr = kt * 32 + ql;
            const ALAS unsigned char* krow = kbase + kvr * 128;
            const int ksw = (kvr >> 1) & 7;
            f32x16 p;
#pragma unroll
            for (int r = 0; r < 16; ++r) p[r] = 0.f;
#pragma unroll
            for (int ds = 0; ds < 4; ++ds) {
                const bf16x8 kf = *(const ALAS bf16x8*)(krow + (((2 * ds + hi) ^ ksw) * 16));
                p = __builtin_amdgcn_mfma_f32_32x32x16_bf16(kf, qr[qt][ds], p, 0, 0, 0);
            }
            const ALAS float* bp = bt + (32 + 32 * ktp - ql + 4 * hi);
            float tmax = -INFINITY;
#pragma unroll
            for (int r = 0; r < 16; ++r) {
                const int kk = (r & 3) + 8 * (r >> 2);
                float s = p[r] + bp[kk];
                const int kin = kk + 4 * hi;
                if (ktp == 0) { if (kin < ql) s = -INFINITY; }
                if (ktp == 8) { if (kin > ql) s = -INFINITY; }
                p[r] = s; tmax = fmaxf(tmax, s);
            }
            tmax = fmaxf(tmax, __shfl_xor(tmax, 32));
            const float mnew = fmaxf(mrun, tmax);
            const float f = __builtin_amdgcn_exp2f(mrun - mnew);
            mrun = mnew;
            float psum = 0.f;
#pragma unroll
            for (int r = 0; r < 16; ++r) { p[r] = __builtin_amdgcn_exp2f(p[r] - mnew); psum += p[r]; }
            lrun = lrun * f + psum;
#pragma unroll
            for (int r = 0; r < 16; ++r) { o0[r] *= f; o1[r] *= f; }
#pragma unroll
            for (int s = 0; s < 2; ++s) {
                u32x4 pw; pw.x = cvtpk(p[8 * s + 0], p[8 * s + 1]); pw.y = cvtpk(p[8 * s + 2], p[8 * s + 3]); pw.z = cvtpk(p[8 * s + 4], p[8 * s + 5]); pw.w = cvtpk(p[8 * s + 6], p[8 * s + 7]);
                const bf16x8 pf = __builtin_bit_cast(bf16x8, pw);
                const ALAS unsigned char* vp = lds + LDS_V + (4 * kt + 2 * s) * 512 + vlane;
                const s16x4 a0 = __builtin_bit_cast(s16x4, __builtin_amdgcn_ds_read_tr16_b64_v4i16((ALAS v4i16_t*)(vp)));
                const s16x4 a1 = __builtin_bit_cast(s16x4, __builtin_amdgcn_ds_read_tr16_b64_v4i16((ALAS v4i16_t*)(vp + 512)));
                const s16x4 b0 = __builtin_bit_cast(s16x4, __builtin_amdgcn_ds_read_tr16_b64_v4i16((ALAS v4i16_t*)(vp + 24576)));
                const s16x4 b1 = __builtin_bit_cast(s16x4, __builtin_amdgcn_ds_read_tr16_b64_v4i16((ALAS v4i16_t*)(vp + 24576 + 512)));
                const bf16x8 vf0 = (bf16x8){a0[0], a0[1], a0[2], a0[3], a1[0], a1[1], a1[2], a1[3]};
                const bf16x8 vf1 = (bf16x8){b0[0], b0[1], b0[2], b0[3], b1[0], b1[1], b1[2], b1[3]};
                o0 = __builtin_amdgcn_mfma_f32_32x32x16_bf16(vf0, pf, o0, 0, 0, 0);
                o1 = __builtin_amdgcn_mfma_f32_32x32x16_bf16(vf1, pf, o1, 0, 0, 0);
            }
        }
        const float ltot = lrun + __shfl_xor(lrun, 32);
        const float inv = 1.0f / ltot;
        bf16_t* orow = O + (size_t)(R0 + qt * 32 + ql) * O_LD + h * 64 + 4 * hi;
#pragma unroll
        for (int rg = 0; rg < 4; ++rg) {
            u32x2 w0, w1;
            w0.x = cvtpk(o0[4 * rg] * inv, o0[4 * rg + 1] * inv); w0.y = cvtpk(o0[4 * rg + 2] * inv, o0[4 * rg + 3] * inv);
            w1.x = cvtpk(o1[4 * rg] * inv, o1[4 * rg + 1] * inv); w1.y = cvtpk(o1[4 * rg + 2] * inv, o1[4 * rg + 3] * inv);
            *(u32x2*)(orow + 8 * rg) = w0; *(u32x2*)(orow + 32 + 8 * rg) = w1;
        }
    }
    __syncthreads();
}
}
constexpr int NWAVES = 8;
constexpr int D = 1024, FF = 4096, PLE = 256, DEPTH = 4;
constexpr int MP = 65536, MS = 16384, M = MP + MS;
constexpr int SEQ_P = 4096, SEQ_S = 2048;
constexpr int NQKV = 1536, NCIN = 3072;
constexpr size_t MiB = 1u << 20;
constexpr size_t WS_BIAS = 0;
constexpr size_t WS_SINK = 32 * 1024;
constexpr size_t WS_SS = 948 * MiB;
constexpr size_t WS_W = 8 * MiB;
constexpr size_t WS_XB = 108 * MiB;
constexpr size_t WS_PB = 268 * MiB;
constexpr size_t WS_H = 308 * MiB;
constexpr size_t SLOT = 160 * MiB;
constexpr size_t WS_END = WS_H + 4 * SLOT + 12 * MiB;
constexpr size_t W_QKV = 0;
constexpr size_t W_O = W_QKV + 2ull * NQKV * D;
constexpr size_t W_CIN = W_O + 2ull * D * D;
constexpr size_t W_COUT = W_CIN + 2ull * NCIN * D;
constexpr size_t W_UP = W_COUT + 2ull * D * D;
constexpr size_t W_DN = W_UP + 4ull * FF * D;
constexpr size_t W_G = W_DN + 4ull * FF * D;
constexpr size_t W_P = W_G + 4ull * D * D;
constexpr size_t W_TOTAL = W_P + 4ull * D * PLE;
static_assert(W_TOTAL * 2 <= 100 * MiB, "weight region");
constexpr int LDS_BYTES = 147456;
static_assert(pg8::STAGE_BYTES <= 131072 && attn::LDS_BYTES <= 131072, "LDS map");

#define LAS __attribute__((address_space(3)))
typedef unsigned short bf16;
typedef unsigned v4u __attribute__((ext_vector_type(4)));
typedef unsigned v2u __attribute__((ext_vector_type(2)));
typedef float f32x4 __attribute__((ext_vector_type(4)));
__device__ __forceinline__ unsigned f2bf(float f) { unsigned u = __builtin_bit_cast(unsigned, f); return (u + 0x7fffu + ((u >> 16) & 1u)) >> 16; }
__device__ __forceinline__ unsigned pk2(float lo, float hi) { return f2bf(lo) | (f2bf(hi) << 16); }
__device__ __forceinline__ float wave_sum(float v) {
#pragma unroll
    for (int o = 1; o < 64; o <<= 1) v += __shfl_xor(v, o);
    return v;
}

struct Args {
    const float* in[19];
    float* out; unsigned char* ws;
    int ph_lo, ph_hi;
};

__device__ __forceinline__ int cin_row(int n) { if (n < 1024) return n; if (n < 2048) { const int c = n - 1024; return 1024 + (c >> 7) * 256 + (c & 127); } const int c = n - 2048; return 1024 + (c >> 7) * 256 + 128 + (c & 127); }
__device__ __forceinline__ void transpose_item(const float* __restrict__ W, int K, int N, bf16* __restrict__ WT, const float* __restrict__ gk, int mode, LAS float* scr, int item, int lane) {
    const int nblk = N / 32, kb = item / nblk, nb = item % nblk, k0 = 64 * kb, n0 = 32 * nb;
#pragma unroll 8
    for (int i = 0; i < 32; ++i) { const int kk = 2 * i + (lane >> 5); float v = W[(size_t)(k0 + kk) * N + n0 + (lane & 31)]; if (gk) v *= gk[k0 + kk]; scr[kk * 33 + (lane & 31)] = v; }
    asm volatile("s_waitcnt lgkmcnt(0)" ::: "memory");
    const int c = lane & 7;
    const int r0 = mode ? cin_row(n0) : n0;
#pragma unroll
    for (int j = 0; j < 4; ++j) { const int n = (lane >> 3) + 8 * j; const LAS float* s = scr + (8 * c) * 33 + n;
        v4u o; o.x = pk2(s[0 * 33], s[1 * 33]); o.y = pk2(s[2 * 33], s[3 * 33]); o.z = pk2(s[4 * 33], s[5 * 33]); o.w = pk2(s[6 * 33], s[7 * 33]);
        *(v4u*)(WT + (size_t)(r0 + n) * K + k0 + 8 * c) = o; }
    asm volatile("s_waitcnt lgkmcnt(0)" ::: "memory");
}

__device__ __forceinline__ int t5_bucket(int rel) {
    const int n = rel < 0 ? -rel : rel; int b;
    if (n < 8) b = n; else { b = 8 + (n >= 12) + (n >= 16) + (n >= 23) + (n >= 32) + (n >= 46) + (n >= 64) + (n >= 91); if (b > 15) b = 15; }
    return (rel > 0 ? 16 : 0) + b;
}

__global__ void __launch_bounds__(NWAVES * 64, 2) fwd_kernel(Args a) {
    extern __shared__ __attribute__((aligned(16))) unsigned char lds_raw[];
    LAS unsigned char* lds = (LAS unsigned char*)lds_raw;
    cg::grid_group grid = cg::this_grid();
    const int G = gridDim.x, bx = blockIdx.x;
    const int NGW = G * NWAVES, NGT = G * NWAVES * 64;
#define TID_LOCALS() int tid_ = threadIdx.x; asm volatile("" : "+v"(tid_)); const int tid = tid_, lane = tid & 63, wave = __builtin_amdgcn_readfirstlane(tid >> 6), gw = bx * NWAVES + wave, gt = bx * (NWAVES * 64) + tid; (void)lane; (void)gw; (void)gt;
    unsigned char* ws = a.ws;
    const float* x_prompt = a.in[0]; const float* x_sample = a.in[1]; const float* p_prompt = a.in[2]; const float* p_sample = a.in[3];
    const float* rel_bias = a.in[4]; const float* attn_w_qkv = a.in[5]; const float* attn_w_o = a.in[6]; const float* attn_sink = a.in[7];
    const float* conv_w_in = a.in[8]; const float* conv_w = a.in[9]; const float* conv_w_out = a.in[10]; const float* mlp_w_up = a.in[11];
    const float* mlp_w_down = a.in[12]; const float* ple_w_gate = a.in[13]; const float* ple_w_proj = a.in[14];
    const float* norm_mix = a.in[15]; const float* norm_mlp = a.in[16]; const float* norm_ple = a.in[17]; const float* final_norm = a.in[18];
    float* out = a.out;
    float* biasg = (float*)(ws + WS_BIAS); float* sink2 = (float*)(ws + WS_SINK); float* SS = (float*)(ws + WS_SS);
    bf16* Wb = (bf16*)(ws + WS_W); bf16* XBm = (bf16*)(ws + WS_XB); bf16* PB = (bf16*)(ws + WS_PB);
    bf16* S0 = (bf16*)(ws + WS_H); bf16* S2 = (bf16*)(ws + WS_H + 2 * SLOT); bf16* S3 = (bf16*)(ws + WS_H + 3 * SLOT);
    const int lo = a.ph_lo, hi = a.ph_hi;
    int ph = 0;
#define IN_PH() (lo <= ph && ph < hi)
#define SEAM() do { if (lo <= ph && ph + 1 < hi) { asm volatile("s_waitcnt vmcnt(0) lgkmcnt(0)" ::: "memory"); __builtin_amdgcn_fence(__ATOMIC_RELEASE, "agent"); grid.sync(); __builtin_amdgcn_fence(__ATOMIC_ACQUIRE, "agent"); asm volatile("s_waitcnt vmcnt(0)" ::: "memory"); } ++ph; } while (0)

    if (IN_PH()) {
        TID_LOCALS();
        LAS float* scr = (LAS float*)(lds + wave * 16384);
        constexpr int I_QKV = 16 * 48, I_CIN = 16 * 96, I_SQ = 16 * 32, I_UP = 16 * 128, I_DN = 64 * 32, I_P = 4 * 32;
        constexpr int L_EVEN = I_QKV + I_SQ + I_UP + I_DN + I_SQ + I_P, L_ODD = I_CIN + I_SQ + I_UP + I_DN + I_SQ + I_P;
        constexpr int NITEMS = 2 * (L_EVEN + L_ODD);
        for (int it = gw; it < NITEMS; it += NGW) {
            int r = it; const int pair = r / (L_EVEN + L_ODD); r -= pair * (L_EVEN + L_ODD);
            int i = 2 * pair; if (r >= L_EVEN) { r -= L_EVEN; i += 1; }
            const int j = pair; const bool odd = i & 1;
            const int I_IN = odd ? I_CIN : I_QKV;
            if (r < I_IN) {
                if (odd) transpose_item(conv_w_in + (size_t)j * D * NCIN, D, NCIN, Wb + W_CIN + (size_t)j * NCIN * D, norm_mix + i * D, 1, scr, r, lane);
                else transpose_item(attn_w_qkv + (size_t)j * D * NQKV, D, NQKV, Wb + W_QKV + (size_t)j * NQKV * D, norm_mix + i * D, 0, scr, r, lane);
                continue; }
            r -= I_IN;
            if (r < I_SQ) {
                if (odd) transpose_item(conv_w_out + (size_t)j * D * D, D, D, Wb + W_COUT + (size_t)j * D * D, nullptr, 0, scr, r, lane);
                else transpose_item(attn_w_o + (size_t)j * D * D, D, D, Wb + W_O + (size_t)j * D * D, nullptr, 0, scr, r, lane);
                continue; }
            r -= I_SQ;
            if (r < I_UP) { transpose_item(mlp_w_up + (size_t)i * D * FF, D, FF, Wb + W_UP + (size_t)i * FF * D, norm_mlp + i * D, 0, scr, r, lane); continue; }
            r -= I_UP;
            if (r < I_DN) { transpose_item(mlp_w_down + (size_t)i * FF * D, FF, D, Wb + W_DN + (size_t)i * D * FF, nullptr, 0, scr, r, lane); continue; }
            r -= I_DN;
            if (r < I_SQ) { transpose_item(ple_w_gate + (size_t)i * D * D, D, D, Wb + W_G + (size_t)i * D * D, norm_ple + i * D, 0, scr, r, lane); continue; }
            r -= I_SQ;
            transpose_item(ple_w_proj + (size_t)i * PLE * D, PLE, D, Wb + W_P + (size_t)i * D * PLE, nullptr, 0, scr, r, lane);
        }
        for (int m = gw; m < M; m += NGW) {
            const float* xr = (m < MP) ? x_prompt + (size_t)m * D : x_sample + (size_t)(m - MP) * D;
            const f32x4* x4 = (const f32x4*)xr + lane; float s = 0.f; f32x4 v[4];
#pragma unroll
            for (int j = 0; j < 4; ++j) { v[j] = x4[64 * j]; s += (v[j].x * v[j].x + v[j].y * v[j].y) + (v[j].z * v[j].z + v[j].w * v[j].w); }
            s = wave_sum(s);
            v2u* o8 = (v2u*)(S3 + (size_t)m * D) + lane;
#pragma unroll
            for (int j = 0; j < 4; ++j) { v2u w; w.x = pk2(v[j].x, v[j].y); w.y = pk2(v[j].z, v[j].w); o8[64 * j] = w; }
            if (lane < 16) SS[(size_t)m * 16 + lane] = (lane == 0) ? s : 0.f;
        }
        for (int i = gt; i < 16 * 320; i += NGT) {
            const int h = i / 320, e = i % 320, t = e - 32; float v = 0.f;
            if (t >= 0 && t <= 256) v = rel_bias[t5_bucket(t - 128) * 16 + h] * 1.4426950408889634f;
            biasg[i] = v;
        }
        if (gt < 32) sink2[gt] = attn_sink[gt] * 1.4426950408889634f;
    }
    SEAM();

#pragma unroll 1
    for (int i = 0; i < DEPTH; ++i) {
        const int j = i >> 1; const bool odd = i & 1;
        if (IN_PH()) {
            TID_LOCALS();
            const float* pp = p_prompt + (size_t)i * MP * PLE; const float* ps = p_sample + (size_t)i * MS * PLE;
            for (int c = gt; c < M * PLE / 8; c += NGT) {
                const size_t e = (size_t)c * 8;
                const float* src = (e < (size_t)MP * PLE) ? pp + e : ps + (e - (size_t)MP * PLE);
                const f32x4 a0 = *(const f32x4*)src, a1 = *(const f32x4*)(src + 4);
                v4u w; w.x = pk2(a0.x, a0.y); w.y = pk2(a0.z, a0.w); w.z = pk2(a1.x, a1.y); w.w = pk2(a1.z, a1.w);
                *(v4u*)(PB + e) = w;
            }
            if (!odd) {
                pg8::Gemm g{S3, Wb + W_QKV + (size_t)j * NQKV * D, M, NQKV, D}; pg8::StaticOrder S; S.init(M, NQKV, G, bx);
                pg8::EpiBf16R<1> E{S0, NQKV, SS + (size_t)((3 * i) & 1) * M * 16};
#ifndef NO_QKV
                pg8::gemm_phase<pg8::EpiBf16R<1>, pg8::StaticOrder, true, true>(lds, g, S, E);
#endif
            } else {
                pg8::Gemm g{S3, Wb + W_CIN + (size_t)j * NCIN * D, M, NCIN, D}; pg8::StaticOrder S; S.init(M, NCIN, G, bx);
                pg8::EpiBf16R<3> E{S0, 2048, SS + (size_t)((3 * i) & 1) * M * 16};
#ifndef NO_CIN
                pg8::gemm_phase<pg8::EpiBf16R<3>, pg8::StaticOrder, true, true>(lds, g, S, E);
#endif
            }
        }
        SEAM();
        if (IN_PH()) {
            TID_LOCALS();
            if (!odd) {
                for (int u = bx; u < 640 * 4; u += G) {
                    const int sb = u >> 2, g = u & 3; int rowbase, q0, S;
                    if (sb < 512) { rowbase = (sb >> 5) * SEQ_P; q0 = (sb & 31) * 128; S = SEQ_P; }
                    else { const int t = sb - 512; rowbase = MP + (t >> 4) * SEQ_S; q0 = (t & 15) * 128; S = SEQ_S; }
#ifndef NO_ATTN
                    attn::attn_unit(lds, S0, S2, biasg, sink2 + j * 16, rowbase, q0, S, g);
#endif
                }
            } else {
                const float* cw = conv_w + (size_t)j * 3 * D;
                for (int c = gt; c < M * (D / 8); c += NGT) {
                    const int row = c >> 7, c8 = (c & 127) * 8;
                    const int pos = (row < MP) ? (row & (SEQ_P - 1)) : ((row - MP) & (SEQ_S - 1));
                    const int Sq = (row < MP) ? SEQ_P : SEQ_S;
                    const bf16* bz = S0 + (size_t)row * 2048;
                    const v4u bb = *(const v4u*)(bz + c8), zc = *(const v4u*)(bz + 1024 + c8);
                    v4u zm = (v4u){0u, 0u, 0u, 0u}, zp = (v4u){0u, 0u, 0u, 0u};
                    if (pos > 0) zm = *(const v4u*)(bz - 2048 + 1024 + c8);
                    if (pos < Sq - 1) zp = *(const v4u*)(bz + 2048 + 1024 + c8);
                    const f32x4 w0a = *(const f32x4*)(cw + c8), w0b = *(const f32x4*)(cw + c8 + 4), w1a = *(const f32x4*)(cw + D + c8), w1b = *(const f32x4*)(cw + D + c8 + 4),
                                w2a = *(const f32x4*)(cw + 2 * D + c8), w2b = *(const f32x4*)(cw + 2 * D + c8 + 4);
                    float r[8];
#define CV(e, W0, W1, W2, ZM, ZC, ZP, BB, LOHI) r[e] = LOHI(BB) * (W0 * LOHI(ZM) + W1 * LOHI(ZC) + W2 * LOHI(ZP))
                    CV(0, w0a.x, w1a.x, w2a.x, zm.x, zc.x, zp.x, bb.x, pg8::bf_lo); CV(1, w0a.y, w1a.y, w2a.y, zm.x, zc.x, zp.x, bb.x, pg8::bf_hi);
                    CV(2, w0a.z, w1a.z, w2a.z, zm.y, zc.y, zp.y, bb.y, pg8::bf_lo); CV(3, w0a.w, w1a.w, w2a.w, zm.y, zc.y, zp.y, bb.y, pg8::bf_hi);
                    CV(4, w0b.x, w1b.x, w2b.x, zm.z, zc.z, zp.z, bb.z, pg8::bf_lo); CV(5, w0b.y, w1b.y, w2b.y, zm.z, zc.z, zp.z, bb.z, pg8::bf_hi);
                    CV(6, w0b.z, w1b.z, w2b.z, zm.w, zc.w, zp.w, bb.w, pg8::bf_lo); CV(7, w0b.w, w1b.w, w2b.w, zm.w, zc.w, zp.w, bb.w, pg8::bf_hi);
#undef CV
                    v4u w; w.x = pk2(r[0], r[1]); w.y = pk2(r[2], r[3]); w.z = pk2(r[4], r[5]); w.w = pk2(r[6], r[7]);
                    *(v4u*)(S2 + (size_t)row * D + c8) = w;
                }
            }
        }
        SEAM();
        if (IN_PH()) {
            pg8::Gemm g{S2, odd ? Wb + W_COUT + (size_t)j * D * D : Wb + W_O + (size_t)j * D * D, M, D, D}; pg8::StaticOrder S; S.init(M, D, G, bx);
            pg8::EpiResid<0> E{i == 0 ? x_prompt : out, i == 0 ? x_sample : out + (size_t)MP * D, out, XBm, SS + (size_t)((3 * i + 1) & 1) * M * 16, nullptr, nullptr};
#ifndef NO_MIXOUT
            pg8::gemm_phase<pg8::EpiResid<0>, pg8::StaticOrder, true, true>(lds, g, S, E);
#endif
        }
        SEAM();
        if (IN_PH()) {
            pg8::Gemm g{XBm, Wb + W_UP + (size_t)i * FF * D, M, FF, D}; pg8::StaticOrder S; S.init(M, FF, G, bx);
            pg8::EpiBf16R<2> E{S0, FF, SS + (size_t)((3 * i + 1) & 1) * M * 16};
#ifndef NO_UP
            pg8::gemm_phase<pg8::EpiBf16R<2>, pg8::StaticOrder, true, true>(lds, g, S, E);
#endif
        }
        SEAM();
        if (IN_PH()) {
            pg8::Gemm g{S0, Wb + W_DN + (size_t)i * D * FF, M, D, FF}; pg8::StaticOrder S; S.init(M, D, G, bx);
            pg8::EpiResid<0> E{out, out + (size_t)MP * D, out, XBm, SS + (size_t)((3 * i + 2) & 1) * M * 16, nullptr, nullptr};
#ifndef NO_DOWN
            pg8::gemm_phase<pg8::EpiResid<0>, pg8::StaticOrder, true, true>(lds, g, S, E);
#endif
        }
        SEAM();
        if (IN_PH()) {
            {
                pg8::Gemm g{PB, Wb + W_P + (size_t)i * D * PLE, M, D, PLE}; pg8::StaticOrder S; S.init(M, D, G, bx);
                pg8::EpiBf16R<0> E{S0, D, nullptr};
#ifndef NO_PROJ
                pg8::gemm_phase<pg8::EpiBf16R<0>, pg8::StaticOrder, true, true>(lds, g, S, E);
#endif
            }
            {
                pg8::Gemm g{XBm, Wb + W_G + (size_t)i * D * D, M, D, D}; pg8::StaticOrder S; S.init(M, D, G, bx);
                pg8::EpiResid<1> E{out, out + (size_t)MP * D, out, S3, SS + (size_t)((3 * i + 3) & 1) * M * 16, SS + (size_t)((3 * i + 2) & 1) * M * 16, S0};
#ifndef NO_GATE
                pg8::gemm_phase<pg8::EpiResid<1>, pg8::StaticOrder, true, true>(lds, g, S, E);
#endif
            }
        }
        SEAM();
    }
    if (IN_PH()) {
        TID_LOCALS();
        const float* ssf = SS;
        for (int m = gw; m < M; m += NGW) {
            const float rs = pg8::rinv_of(ssf, m);
            f32x4* x4 = (f32x4*)(out + (size_t)m * D) + lane; const f32x4* g4 = (const f32x4*)final_norm + lane;
#pragma unroll
            for (int q = 0; q < 4; ++q) { const f32x4 v = x4[64 * q], gg = g4[64 * q]; x4[64 * q] = v * rs * gg; }
        }
    }
#undef IN_PH
#undef SEAM
}

constexpr int N_PHASES = 1 + 6 * DEPTH + 1;
extern "C" void kernel_launch(void* const* d_in, const int* in_sizes, int n_in, void* d_out, int out_size, void* d_ws, size_t ws_size, hipStream_t stream) {
    static int grid = 0;
    if (grid == 0) {
        if (n_in != 19 || out_size != M * D || ws_size < WS_END) { fprintf(stderr, "kernel_launch: unexpected shapes (n_in %d out %d ws %zu need %zu)\n", n_in, out_size, ws_size, (size_t)WS_END); grid = -1; return; }
        int dev = 0, cus = 0, per_cu = 0;
        hipGetDevice(&dev); hipDeviceGetAttribute(&cus, hipDeviceAttributeMultiprocessorCount, dev);
        if (hipFuncSetAttribute((const void*)fwd_kernel, hipFuncAttributeMaxDynamicSharedMemorySize, LDS_BYTES) != hipSuccess) { fprintf(stderr, "hipFuncSetAttribute failed\n"); grid = -1; return; }
        if (hipOccupancyMaxActiveBlocksPerMultiprocessor(&per_cu, (const void*)fwd_kernel, NWAVES * 64, LDS_BYTES) != hipSuccess || per_cu < 1) { fprintf(stderr, "occupancy query failed (%d)\n", per_cu); per_cu = 1; (void)hipGetLastError(); }
        grid = cus * per_cu;
    }
    if (grid < 0) return;
    Args a{};
    for (int i = 0; i < 19; ++i) a.in[i] = (const float*)d_in[i];
    a.out = (float*)d_out; a.ws = (unsigned char*)d_ws;
#if defined(MK_MULTI)
    for (int p = 0; p < N_PHASES; ++p) { a.ph_lo = p; a.ph_hi = p + 1; hipLaunchKernelGGL(fwd_kernel, dim3(grid), dim3(NWAVES * 64), LDS_BYTES, stream, a); }
#else
    a.ph_lo = 0; a.ph_hi = N_PHASES;
    void* args[] = {&a};
    hipError_t e = hipLaunchCooperativeKernel((const void*)fwd_kernel, dim3(grid), dim3(NWAVES * 64), args, LDS_BYTES, stream);
    if (e != hipSuccess) fprintf(stderr, "cooperative launch failed: %s (grid %d)\n", hipGetErrorString(e), grid);
#endif
}
```

```cpp
#include <hip/hip_runtime.h>
#include <hip/hip_cooperative_groups.h>
#include <cstdio>
#include <cstdint>
namespace cg = cooperative_groups;
namespace pg8 {
#define PG8_LAS __attribute__((address_space(3)))
typedef unsigned short bf16_t;
typedef short bf16x8 __attribute__((ext_vector_type(8)));
typedef float f32x4 __attribute__((ext_vector_type(4)));
typedef unsigned u32x4 __attribute__((ext_vector_type(4)));
constexpr int BM = 256, BK = 64, HALF = 128, HTB = HALF * BK * 2  , STAGE_BYTES = 8 * HTB, NXCD = 8, WGM = 8;

__host__ __device__ __forceinline__ int lds_byte(int r, int c) { const int st = (r >> 4) * 2 + (c >> 5), rr = r & 15, cc = c & 31, ob = rr * 64 + cc * 2; return st * 1024 + (ob ^ (((ob >> 9) & 1) << 5)); }
__host__ __device__ __forceinline__ void stage_rc(int b, int& R, int& C) { const int st = b / 1024, sb = b % 1024, swz = sb ^ (((sb >> 9) & 1) << 5); R = (st >> 1) * 16 + swz / 64; C = (st & 1) * 32 + (swz % 64) / 2; }
__host__ __device__ __forceinline__ int perm32(int rho) { const int n = rho >> 4, i = rho & 15; return 8 * (i >> 2) + 4 * n + (i & 3); }

struct Unit { int pm, pn; };
struct Gemm { const bf16_t* A; const bf16_t* Bt; int M, N, K; };

struct StaticOrder {
    int nM, nN, nwg, G, c;
    __host__ __device__ void init(int M, int N, int G_, int c_) { nM = M / BM; nN = N / BM; nwg = nM * nN; G = G_; c = c_; }
    __host__ __device__ bool next(int i, Unit& u) const {
        const long L = (long)i * G + c; if (L >= nwg) return false;
        int wgid = (int)L; { const int q = nwg / NXCD, r = nwg % NXCD, xcd = wgid % NXCD, off = wgid / NXCD; wgid = (xcd < r ? xcd * (q + 1) : r * (q + 1) + (xcd - r) * q) + off; }
        const int nig = WGM * nN, gid = wgid / nig, fm = gid * WGM, gsz = (nM - fm) < WGM ? (nM - fm) : WGM;
        u.pm = fm + ((wgid % nig) % gsz); u.pn = (wgid % nig) / gsz; return true;
    }
    __device__ __forceinline__ void a_ready(const Unit&) const {}
    __device__ __forceinline__ void done(const Unit&) const {}
};

__device__ __forceinline__ unsigned cvt_pk_bf16(float lo, float hi) { unsigned r; asm volatile("v_cvt_pk_bf16_f32 %0, %1, %2" : "=v"(r) : "v"(lo), "v"(hi)); return r; }
typedef float f32x2 __attribute__((ext_vector_type(2)));
template <class Epi, class Sched, bool ALIGN_EPI = false, bool SP2 = false>
__device__ __forceinline__ void gemm_phase(PG8_LAS unsigned char* lds, const Gemm g, const Sched& S, const Epi& E) {
    int tid_ = threadIdx.x; asm volatile("" : "+v"(tid_));
    const int tid = tid_, wid = __builtin_amdgcn_readfirstlane(tid >> 6), lane = tid & 63, wr = wid >> 2, wc = wid & 3, fr = lane & 15, fq = lane >> 4;
    int K_ = g.K; asm volatile("" : "+s"(K_));
    const int K = K_, nt = K / BK;
    unsigned voffA[2], voffB[2];
#pragma unroll
    for (int i = 0; i < 2; ++i) { int R, C; stage_rc(tid * 16 + i * 8192, R, C); const int Rb = Epi::PERM ? ((R & ~31) + perm32(R & 31)) : R;
        voffA[i] = (unsigned)(R * K + C) * 2u; voffB[i] = (unsigned)(Rb * K + C) * 2u; }
    const size_t kstep = (size_t)(BK * 2);
    const size_t hstep = (size_t)HALF * K * 2;
    const size_t tstep = 2 * hstep;
    const unsigned ldsw = (unsigned)wid * 1024u;
    const int aoff = lds_byte(wr * 64 + fr, fq * 8), boff = lds_byte(wc * 32 + fr, fq * 8);
#define PG8_SA(b, h) (((b) * 2 + (h)) * HTB)
#define PG8_SB(b, h) ((4 + (b) * 2 + (h)) * HTB)
#define PG8_STAGE(bufoff, gbase, voff) do { _Pragma("unroll") for (int _i = 0; _i < 2; ++_i) \
        __builtin_amdgcn_global_load_lds((const unsigned*)((const char*)(gbase) + (voff)[_i]), (PG8_LAS unsigned*)(lds + (bufoff) + ldsw + _i * 8192), 16, 0, 0); } while (0)
#define PG8_LDA(dst, b, h) do { _Pragma("unroll") for (int m = 0; m < 4; ++m) _Pragma("unroll") for (int k = 0; k < 2; ++k) dst[m][k] = *(const PG8_LAS bf16x8*)(lds + PG8_SA(b, h) + aoff + m * 2048 + k * 1024); } while (0)
#define PG8_LDB(dst, b, h) do { _Pragma("unroll") for (int n = 0; n < 2; ++n) _Pragma("unroll") for (int k = 0; k < 2; ++k) dst[n][k] = *(const PG8_LAS bf16x8*)(lds + PG8_SB(b, h) + boff + n * 2048 + k * 1024); } while (0)
#define PG8_MMA(ai, bj, At, Bt) do { __builtin_amdgcn_s_setprio(1); _Pragma("unroll") for (int m = 0; m < 4; ++m) _Pragma("unroll") for (int n = 0; n < 2; ++n) _Pragma("unroll") for (int k = 0; k < 2; ++k) \
        acc[ai][bj][m][n] = __builtin_amdgcn_mfma_f32_16x16x32_bf16(Bt[n][k], At[m][k], acc[ai][bj][m][n], 0, 0, 0); __builtin_amdgcn_s_setprio(0); } while (0)
#define PG8_WAIT_V(n) asm volatile("s_waitcnt vmcnt(" #n ")" ::: "memory")
#define PG8_WAIT_L(n) asm volatile("s_waitcnt lgkmcnt(" #n ")" ::: "memory")
#define PG8_BAR __builtin_amdgcn_s_barrier()
#define PG8_SCHED __builtin_amdgcn_sched_barrier(0)
    Unit cur, nxt; int ui = 0;
    if (!S.next(0, cur)) return;
    f32x4 acc[2][2][4][2];
#pragma unroll
    for (int a = 0; a < 2; ++a)
#pragma unroll
        for (int b = 0; b < 2; ++b)
#pragma unroll
            for (int m = 0; m < 4; ++m)
#pragma unroll
                for (int n = 0; n < 2; ++n) acc[a][b][m][n] = (f32x4){0.f, 0.f, 0.f, 0.f};
    bf16x8 At[4][2], B0[2][2], B1[2][2];
    const char* cA = (const char*)g.A + (size_t)cur.pm * tstep; const char* cB = (const char*)g.Bt + (size_t)cur.pn * tstep;
    S.a_ready(cur);
    if constexpr (SP2) {
        PG8_STAGE(PG8_SB(0, 0), cB, voffB); PG8_STAGE(PG8_SB(0, 1), cB + hstep, voffB); PG8_STAGE(PG8_SA(0, 0), cA, voffA); PG8_STAGE(PG8_SA(0, 1), cA + hstep, voffA);
        if (wr == 1) PG8_BAR;
        PG8_WAIT_V(2); PG8_BAR;
        PG8_STAGE(PG8_SB(1, 0), cB + kstep, voffB); PG8_STAGE(PG8_SA(1, 0), cA + kstep, voffA); PG8_STAGE(PG8_SB(1, 1), cB + hstep + kstep, voffB);
        PG8_WAIT_V(6); PG8_BAR;
    } else {
        PG8_STAGE(PG8_SB(0, 0), cB, voffB); PG8_STAGE(PG8_SA(0, 0), cA, voffA); PG8_STAGE(PG8_SB(0, 1), cB + hstep, voffB); PG8_STAGE(PG8_SA(0, 1), cA + hstep, voffA);
        if (wr == 1) PG8_BAR;
        PG8_WAIT_V(4); PG8_BAR;
        PG8_STAGE(PG8_SB(1, 0), cB + kstep, voffB); PG8_STAGE(PG8_SA(1, 0), cA + kstep, voffA); PG8_STAGE(PG8_SB(1, 1), cB + hstep + kstep, voffB);
        PG8_WAIT_V(6); PG8_BAR;
    }
    for (;;) {
        const bool has_next = S.next(ui + 1, nxt);
        const char* nA = has_next ? (const char*)g.A + (size_t)nxt.pm * tstep : cA; const char* nB = has_next ? (const char*)g.Bt + (size_t)nxt.pn * tstep : cB;
        for (int t = 0; t < nt; t += 2) {
            const bool last = (t == nt - 2);
            const char* a1 = cA + (size_t)(t + 1) * kstep;
            const char* a2 = last ? nA : cA + (size_t)(t + 2) * kstep; const char* b2 = last ? nB : cB + (size_t)(t + 2) * kstep;
            const char* a3 = a2 + kstep; const char* b3 = b2 + kstep;
            if (last && has_next) S.a_ready(nxt);
            if constexpr (SP2) {
            PG8_LDB(B0, 0, 0); PG8_LDB(B1, 0, 1); PG8_SCHED; PG8_LDA(At, 0, 0); PG8_STAGE(PG8_SA(1, 1), a1 + hstep, voffA);
            PG8_WAIT_V(8); PG8_WAIT_L(0); PG8_BAR; PG8_MMA(0, 0, At, B0); PG8_MMA(0, 1, At, B1); PG8_BAR; PG8_SCHED;
            PG8_LDA(At, 0, 1); PG8_STAGE(PG8_SB(0, 0), b2, voffB); PG8_STAGE(PG8_SB(0, 1), b2 + hstep, voffB); PG8_STAGE(PG8_SA(0, 0), a2, voffA);
            PG8_WAIT_V(8); PG8_WAIT_L(0); PG8_BAR; PG8_MMA(1, 0, At, B0); PG8_MMA(1, 1, At, B1); PG8_BAR; PG8_SCHED;
            PG8_LDB(B0, 1, 0); PG8_LDB(B1, 1, 1); PG8_SCHED; PG8_LDA(At, 1, 0); PG8_STAGE(PG8_SA(0, 1), a2 + hstep, voffA);
            PG8_WAIT_V(8); PG8_WAIT_L(0); PG8_BAR; PG8_MMA(0, 0, At, B0); PG8_MMA(0, 1, At, B1); PG8_BAR; PG8_SCHED;
            PG8_LDA(At, 1, 1); PG8_STAGE(PG8_SB(1, 0), b3, voffB); PG8_STAGE(PG8_SB(1, 1), b3 + hstep, voffB); PG8_STAGE(PG8_SA(1, 0), a3, voffA);
            PG8_WAIT_V(8); PG8_WAIT_L(0); PG8_BAR; PG8_MMA(1, 0, At, B0); PG8_MMA(1, 1, At, B1); PG8_BAR; PG8_SCHED;
            } else {
            PG8_LDB(B0, 0, 0); PG8_SCHED; PG8_LDA(At, 0, 0); PG8_STAGE(PG8_SA(1, 1), a1 + hstep, voffA);
            PG8_WAIT_L(8); PG8_BAR; PG8_WAIT_L(0); PG8_MMA(0, 0, At, B0); PG8_BAR; PG8_SCHED;
            PG8_LDB(B1, 0, 1); PG8_STAGE(PG8_SB(0, 0), b2, voffB);
            PG8_BAR; PG8_WAIT_L(0); PG8_MMA(0, 1, At, B1); PG8_BAR;
            PG8_LDA(At, 0, 1); PG8_STAGE(PG8_SA(0, 0), a2, voffA);
            PG8_BAR; PG8_WAIT_L(0); PG8_MMA(1, 0, At, B0); PG8_BAR; PG8_SCHED;
            PG8_STAGE(PG8_SB(0, 1), b2 + hstep, voffB);
            PG8_WAIT_V(6); PG8_BAR; PG8_MMA(1, 1, At, B1); PG8_BAR;
            PG8_LDB(B0, 1, 0); PG8_SCHED; PG8_LDA(At, 1, 0); PG8_STAGE(PG8_SA(0, 1), a2 + hstep, voffA);
            PG8_WAIT_L(8); PG8_BAR; PG8_WAIT_L(0); PG8_MMA(0, 0, At, B0); PG8_BAR; PG8_SCHED;
            PG8_LDB(B1, 1, 1); PG8_STAGE(PG8_SB(1, 0), b3, voffB);
            PG8_BAR; PG8_WAIT_L(0); PG8_MMA(0, 1, At, B1); PG8_BAR;
            PG8_LDA(At, 1, 1); PG8_STAGE(PG8_SA(1, 0), a3, voffA);
            PG8_BAR; PG8_WAIT_L(0); PG8_MMA(1, 0, At, B0); PG8_BAR; PG8_SCHED;
            PG8_STAGE(PG8_SB(1, 1), b3 + hstep, voffB);
            PG8_WAIT_V(6); PG8_BAR; PG8_MMA(1, 1, At, B1); PG8_BAR;
            }
        }
        if constexpr (ALIGN_EPI) { if (wr == 0) PG8_BAR; }
        if constexpr (!Epi::AFTER_DRAIN) { E(acc, cur, wr, wc, fr, fq); S.done(cur); }
        if (!has_next) break;
#pragma unroll
        for (int a = 0; a < 2; ++a)
#pragma unroll
            for (int b = 0; b < 2; ++b)
#pragma unroll
                for (int m = 0; m < 4; ++m)
#pragma unroll
                    for (int n = 0; n < 2; ++n) acc[a][b][m][n] = (f32x4){0.f, 0.f, 0.f, 0.f};
        cur = nxt; cA = nA; cB = nB; ++ui;
        if constexpr (ALIGN_EPI) { if (wr == 1) PG8_BAR; }
    }
    PG8_WAIT_V(0);
    if constexpr (!ALIGN_EPI) { if (wr == 0) PG8_BAR; }
    PG8_BAR;
    if constexpr (Epi::AFTER_DRAIN) { E.fused(acc, cur, wr, wc, fr, fq, lds, wid, lane); S.done(cur); }
#undef PG8_SA
#undef PG8_SB
#undef PG8_STAGE
#undef PG8_LDA
#undef PG8_LDB
#undef PG8_MMA
#undef PG8_WAIT_V
#undef PG8_WAIT_L
#undef PG8_BAR
#undef PG8_SCHED
}
}
namespace pg8 {
constexpr float QSCALE = 0.125f * 1.4426950408889634f;
constexpr float RMS_EPS = 1e-6f;
constexpr int MP_ROWS = 65536;
__device__ __forceinline__ float ss_sum(const float* ss, int row) { const f32x4* p = (const f32x4*)(ss + (size_t)row * 16); const f32x4 a = p[0], b = p[1], c = p[2], d = p[3];
    return (((a[0] + a[1]) + (a[2] + a[3])) + ((b[0] + b[1]) + (b[2] + b[3]))) + (((c[0] + c[1]) + (c[2] + c[3])) + ((d[0] + d[1]) + (d[2] + d[3]))); }
__device__ __forceinline__ float rinv_of(const float* ss, int row) { return __builtin_amdgcn_rsqf(ss_sum(ss, row) * (1.0f / 1024.0f) + RMS_EPS); }
__device__ __forceinline__ float bf_lo(unsigned w) { return __uint_as_float(w << 16); }
__device__ __forceinline__ float bf_hi(unsigned w) { return __uint_as_float(w & 0xffff0000u); }

template <int MODE> struct EpiBf16R {
    static constexpr bool PERM = true, AFTER_DRAIN = false;
    bf16_t* O; int ldc; const float* ss;
    __device__ __forceinline__ void operator()(const f32x4 (&acc)[2][2][4][2], const Unit& u, int wr, int wc, int fr, int fq) const {
        const int row0 = u.pm * BM + wr * 64 + fr;
        const int colw = wc * 32 + 8 * fq;
        float sc = 1.f;
        if (MODE == 1) { if (u.pn < 4) sc = QSCALE; }
#pragma unroll
        for (int ai = 0; ai < 2; ++ai)
#pragma unroll
            for (int m = 0; m < 4; ++m) {
                const int row = row0 + ai * HALF + m * 16;
                float rs = sc;
                if (MODE != 0) rs *= rinv_of(ss, row);
                bf16_t* rowp = O + (size_t)row * ldc;
                if (MODE == 3 && u.pn >= 4) {
                    const f32x4 z0 = (acc[ai][0][m][0] * rs) * (acc[ai][1][m][0] * rs), z1 = (acc[ai][0][m][1] * rs) * (acc[ai][1][m][1] * rs);
                    u32x4 w; w.x = cvt_pk_bf16(z0[0], z0[1]); w.y = cvt_pk_bf16(z0[2], z0[3]); w.z = cvt_pk_bf16(z1[0], z1[1]); w.w = cvt_pk_bf16(z1[2], z1[3]);
                    *(u32x4*)(rowp + 1024 + (u.pn - 4) * HALF + colw) = w;
                } else {
#pragma unroll
                    for (int bj = 0; bj < 2; ++bj) {
                        f32x4 v0 = acc[ai][bj][m][0] * rs, v1 = acc[ai][bj][m][1] * rs;
                        if (MODE == 2) {
#pragma unroll
                            for (int e = 0; e < 4; ++e) { const float a = fmaxf(v0[e], 0.f), b = fmaxf(v1[e], 0.f); v0[e] = a * a; v1[e] = b * b; }
                        }
                        u32x4 w; w.x = cvt_pk_bf16(v0[0], v0[1]); w.y = cvt_pk_bf16(v0[2], v0[3]); w.z = cvt_pk_bf16(v1[0], v1[1]); w.w = cvt_pk_bf16(v1[2], v1[3]);
                        *(u32x4*)(rowp + u.pn * BM + bj * HALF + colw) = w;
                    }
                }
            }
    }
};

template <int MODE> struct EpiResid {
    static constexpr bool PERM = true, AFTER_DRAIN = false;
    const bf16_t* xold; bf16_t* xnew; float* ss_next; const float* ss_cur; const bf16_t* T;
    __device__ __forceinline__ void operator()(const f32x4 (&acc)[2][2][4][2], const Unit& u, int wr, int wc, int fr, int fq) const {
        const int row0 = u.pm * BM + wr * 64 + fr;
        const int col0 = u.pn * BM + wc * 32 + 8 * fq;
#pragma unroll
        for (int ai = 0; ai < 2; ++ai)
#pragma unroll
            for (int m = 0; m < 4; ++m) {
                const int row = row0 + ai * HALF + m * 16;
                const size_t roff = (size_t)row * 1024 + col0;
                float rs = 0.f;
                if (MODE == 1) rs = rinv_of(ss_cur, row) * (-1.4426950408889634f);
                float sq = 0.f;
#pragma unroll
                for (int bj = 0; bj < 2; ++bj) {
                    const u32x4 xo = *(const u32x4*)(xold + roff + bj * HALF);
                    f32x4 d0 = acc[ai][bj][m][0], d1 = acc[ai][bj][m][1];
                    if (MODE == 1) {
                        const u32x4 t = *(const u32x4*)(T + roff + bj * HALF);
                        f32x4 t0, t1; t0[0] = bf_lo(t.x); t0[1] = bf_hi(t.x); t0[2] = bf_lo(t.y); t0[3] = bf_hi(t.y); t1[0] = bf_lo(t.z); t1[1] = bf_hi(t.z); t1[2] = bf_lo(t.w); t1[3] = bf_hi(t.w);
#pragma unroll
                        for (int e = 0; e < 4; ++e) {
                            d0[e] = t0[e] * __builtin_amdgcn_rcpf(1.0f + __builtin_amdgcn_exp2f(d0[e] * rs));
                            d1[e] = t1[e] * __builtin_amdgcn_rcpf(1.0f + __builtin_amdgcn_exp2f(d1[e] * rs));
                        }
                    }
                    f32x4 x0, x1; x0[0] = bf_lo(xo.x) + d0[0]; x0[1] = bf_hi(xo.x) + d0[1]; x0[2] = bf_lo(xo.y) + d0[2]; x0[3] = bf_hi(xo.y) + d0[3];
                    x1[0] = bf_lo(xo.z) + d1[0]; x1[1] = bf_hi(xo.z) + d1[1]; x1[2] = bf_lo(xo.w) + d1[2]; x1[3] = bf_hi(xo.w) + d1[3];
                    u32x4 w; w.x = cvt_pk_bf16(x0[0], x0[1]); w.y = cvt_pk_bf16(x0[2], x0[3]); w.z = cvt_pk_bf16(x1[0], x1[1]); w.w = cvt_pk_bf16(x1[2], x1[3]);
                    *(u32x4*)(xnew + roff + bj * HALF) = w;
                    sq += (x0[0] * x0[0] + x0[1] * x0[1]) + (x0[2] * x0[2] + x0[3] * x0[3]) + (x1[0] * x1[0] + x1[1] * x1[1]) + (x1[2] * x1[2] + x1[3] * x1[3]);
                }
                sq += __shfl_xor(sq, 16); sq += __shfl_xor(sq, 32);
                if (fq == 0) ss_next[(size_t)row * 16 + u.pn * 4 + wc] = sq;
            }
    }
};
}
namespace attn {
#define ALAS __attribute__((address_space(3)))
typedef unsigned short bf16_t;
typedef short bf16x8 __attribute__((ext_vector_type(8)));
typedef short s16x4 __attribute__((ext_vector_type(4)));
typedef short v4i16_t __attribute__((ext_vector_type(4)));
typedef float f32x16 __attribute__((ext_vector_type(16)));
typedef unsigned u32x4 __attribute__((ext_vector_type(4)));
typedef unsigned u32x2 __attribute__((ext_vector_type(2)));
constexpr int QKV_LD = 1536, KOFF = 1024, VOFF = 1280, O_LD = 1024;
constexpr int LDS_K = 0, LDS_V = 49152, LDS_BT = 98304, BT_STRIDE = 320, LDS_BYTES = LDS_BT + 4 * BT_STRIDE * 4;
constexpr int BIAS_LD = 320;
__device__ __forceinline__ int crow(int r, int hi) { return (r & 3) + 8 * (r >> 2) + 4 * hi; }
__device__ __forceinline__ unsigned cvtpk(float lo, float hi) { unsigned r; asm volatile("v_cvt_pk_bf16_f32 %0, %1, %2" : "=v"(r) : "v"(lo), "v"(hi)); return r; }

__device__ __forceinline__ void attn_unit(ALAS unsigned char* lds, const bf16_t* __restrict__ QKV, bf16_t* __restrict__ O, const float* __restrict__ biasg, const float* __restrict__ sink2,
                                          int rowbase, int q0, int S, int g) {
    int tid_ = threadIdx.x; asm volatile("" : "+v"(tid_));
    const int tid = tid_, lane = tid & 63, ql = lane & 31, hi = lane >> 5;
    const int wid = __builtin_amdgcn_readfirstlane(tid >> 6);
    const int r4 = wid >> 1, qh = wid & 1, h = g * 4 + r4;
#pragma unroll
    for (int i = 0; i < 6; ++i) {
        const int chunk = tid + 512 * i, kvr = chunk >> 3, c = chunk & 7, pos = q0 - 128 + kvr;
        u32x4 kk = (u32x4){0u, 0u, 0u, 0u}, vv = (u32x4){0u, 0u, 0u, 0u};
        if (pos >= 0 && pos < S) {
            const bf16_t* src = QKV + (size_t)(rowbase + pos) * QKV_LD + g * 64 + c * 8;
            kk = *(const u32x4*)(src + KOFF); vv = *(const u32x4*)(src + VOFF);
        }
        *(ALAS u32x4*)(lds + LDS_K + kvr * 128 + ((c ^ ((kvr >> 1) & 7)) * 16)) = kk;
        *(ALAS u32x4*)(lds + LDS_V + (c >> 2) * 24576 + (kvr >> 3) * 512 + (kvr & 7) * 64 + (c & 3) * 16) = vv;
    }
    for (int i = tid; i < 4 * BT_STRIDE; i += 512) ((ALAS float*)(lds + LDS_BT))[i] = biasg[(g * 4) * BIAS_LD + i];
    const int R0 = rowbase + q0 + qh * 64;
    bf16x8 qr[2][4];
#pragma unroll
    for (int qt = 0; qt < 2; ++qt)
#pragma unroll
        for (int ds = 0; ds < 4; ++ds) qr[qt][ds] = *(const bf16x8*)(QKV + (size_t)(R0 + qt * 32 + ql) * QKV_LD + h * 64 + ds * 16 + hi * 8);
    const float snk = sink2[h];
    __syncthreads();
    const ALAS unsigned char* kbase = lds + LDS_K;
    const ALAS float* bt = (const ALAS float*)(lds + LDS_BT) + r4 * BT_STRIDE;
    const int ktlo = (q0 == 0) ? 4 : 0, kthi = (q0 + 128 >= S) ? 7 : 11;
    const int vlane = (4 * hi + ((lane & 15) >> 2)) * 64 + ((lane >> 4) & 1) * 32 + (lane & 3) * 8;
#pragma unroll
    for (int qt = 0; qt < 2; ++qt) {
        const int ot = qh * 2 + qt;
        int k0 = ot, k1 = ot + 8; if (k0 < ktlo) k0 = ktlo; if (k1 > kthi) k1 = kthi;
        float mrun = snk, lrun = (hi == 0) ? 1.0f : 0.0f;
        f32x16 o0, o1;
#pragma unroll
        for (int r = 0; r < 16; ++r) { o0[r] = 0.f; o1[r] = 0.f; }
        for (int kt = k0; kt <= k1; ++kt) {
            const int ktp = kt - ot;
            const int kvr = kt * 32 + ql;
            const ALAS unsigned char* krow = kbase + kvr * 128;
            const int ksw = (kvr >> 1) & 7;
            f32x16 p;
#pragma unroll
            for (int r = 0; r < 16; ++r) p[r] = 0.f;
#pragma unroll
            for (int ds = 0; ds < 4; ++ds) {
                const bf16x8 kf = *(const ALAS bf16x8*)(krow + (((2 * ds + hi) ^ ksw) * 16));
                p = __builtin_amdgcn_mfma_f32_32x32x16_bf16(kf, qr[qt][ds], p, 0, 0, 0);
            }
            const ALAS float* bp = bt + (32 + 32 * ktp - ql + 4 * hi);
            float tmax = -INFINITY;
#pragma unroll
            for (int r = 0; r < 16; ++r) {
                const int kk = (r & 3) + 8 * (r >> 2);
                float s = p[r] + bp[kk];
                const int kin = kk + 4 * hi;
                if (ktp == 0) { if (kin < ql) s = -INFINITY; }
                if (ktp == 8) { if (kin > ql) s = -INFINITY; }
                p[r] = s; tmax = fmaxf(tmax, s);
            }
            tmax = fmaxf(tmax, __shfl_xor(tmax, 32));
            const float mnew = fmaxf(mrun, tmax);
            const float f = __builtin_amdgcn_exp2f(mrun - mnew);
            mrun = mnew;
            float psum = 0.f;
#pragma unroll
            for (int r = 0; r < 16; ++r) { p[r] = __builtin_amdgcn_exp2f(p[r] - mnew); psum += p[r]; }
            lrun = lrun * f + psum;
#pragma unroll
            for (int r = 0; r < 16; ++r) { o0[r] *= f; o1[r] *= f; }
#pragma unroll
            for (int s = 0; s < 2; ++s) {
                u32x4 pw; pw.x = cvtpk(p[8 * s + 0], p[8 * s + 1]); pw.y = cvtpk(p[8 * s + 2], p[8 * s + 3]); pw.z = cvtpk(p[8 * s + 4], p[8 * s + 5]); pw.w = cvtpk(p[8 * s + 6], p[8 * s + 7]);
                const bf16x8 pf = __builtin_bit_cast(bf16x8, pw);
                const ALAS unsigned char* vp = lds + LDS_V + (4 * kt + 2 * s) * 512 + vlane;
                const s16x4 a0 = __builtin_bit_cast(s16x4, __builtin_amdgcn_ds_read_tr16_b64_v4i16((ALAS v4i16_t*)(vp)));
                const s16x4 a1 = __builtin_bit_cast(s16x4, __builtin_amdgcn_ds_read_tr16_b64_v4i16((ALAS v4i16_t*)(vp + 512)));
                const s16x4 b0 = __builtin_bit_cast(s16x4, __builtin_amdgcn_ds_read_tr16_b64_v4i16((ALAS v4i16_t*)(vp + 24576)));
                const s16x4 b1 = __builtin_bit_cast(s16x4, __builtin_amdgcn_ds_read_tr16_b64_v4i16((ALAS v4i16_t*)(vp + 24576 + 512)));
                const bf16x8 vf0 = (bf16x8){a0[0], a0[1], a0[2], a0[3], a1[0], a1[1], a1[2], a1[3]};
                const bf16x8 vf1 = (bf16x8){b0[0], b0[1], b0[2], b0[3], b1[0], b1[1], b1[2], b1[3]};
                o0 = __builtin_amdgcn_mfma_f32_32x32x16_bf16(vf0, pf, o0, 0, 0, 0);
                o1 = __builtin_amdgcn_mfma_f32_32x32x16_bf16(vf1, pf, o1, 0, 0, 0);
            }
        }
        const float ltot = lrun + __shfl_xor(lrun, 32);
        const float inv = 1.0f / ltot;
        bf16_t* orow = O + (size_t)(R0 + qt * 32 + ql) * O_LD + h * 64 + 4 * hi;
#pragma unroll
        for (int rg = 0; rg < 4; ++rg) {
            u32x2 w0, w1;
            w0.x = cvtpk(o0[4 * rg] * inv, o0[4 * rg + 1] * inv); w0.y = cvtpk(o0[4 * rg + 2] * inv, o0[4 * rg + 3] * inv);
            w1.x = cvtpk(o1[4 * rg] * inv, o1[4 * rg + 1] * inv); w1.y = cvtpk(o1[4 * rg + 2] * inv, o1[4 * rg + 3] * inv);
            *(u32x2*)(orow + 8 * rg) = w0; *(u32x2*)(orow + 32 + 8 * rg) = w1;
        }
    }
    __syncthreads();
}
}
constexpr int NWAVES = 8;
constexpr int D = 1024, FF = 4096, PLE = 256, DEPTH = 4;
constexpr int MP = 65536, MS = 16384, M = MP + MS;
constexpr int SEQ_P = 4096, SEQ_S = 2048;
constexpr int NQKV = 1536, NCIN = 3072;
constexpr size_t MiB = 1u << 20;
constexpr size_t WS_BIAS = 0;
constexpr size_t WS_SINK = 32 * 1024;
constexpr size_t WS_SS = 948 * MiB;
constexpr size_t WS_W = 8 * MiB;
constexpr size_t WS_XB = 108 * MiB;
constexpr size_t WS_PB = 268 * MiB;
constexpr size_t WS_H = 308 * MiB;
constexpr size_t SLOT = 160 * MiB;
constexpr size_t WS_END = WS_H + 4 * SLOT + 12 * MiB;
constexpr size_t W_QKV = 0;
constexpr size_t W_O = W_QKV + 2ull * NQKV * D;
constexpr size_t W_CIN = W_O + 2ull * D * D;
constexpr size_t W_COUT = W_CIN + 2ull * NCIN * D;
constexpr size_t W_UP = W_COUT + 2ull * D * D;
constexpr size_t W_DN = W_UP + 4ull * FF * D;
constexpr size_t W_G = W_DN + 4ull * FF * D;
constexpr size_t W_P = W_G + 4ull * D * D;
constexpr size_t W_TOTAL = W_P + 4ull * D * PLE;
static_assert(W_TOTAL * 2 <= 100 * MiB, "weight region");
constexpr int LDS_BYTES = 147456;
static_assert(pg8::STAGE_BYTES <= 131072 && attn::LDS_BYTES <= 131072, "LDS map");

#define LAS __attribute__((address_space(3)))
typedef unsigned short bf16;
typedef unsigned v4u __attribute__((ext_vector_type(4)));
typedef unsigned v2u __attribute__((ext_vector_type(2)));
typedef float f32x4 __attribute__((ext_vector_type(4)));
__device__ __forceinline__ unsigned f2bf(float f) { unsigned u = __builtin_bit_cast(unsigned, f); return (u + 0x7fffu + ((u >> 16) & 1u)) >> 16; }
__device__ __forceinline__ unsigned pk2(float lo, float hi) { return f2bf(lo) | (f2bf(hi) << 16); }
__device__ __forceinline__ float wave_sum(float v) {
#pragma unroll
    for (int o = 1; o < 64; o <<= 1) v += __shfl_xor(v, o);
    return v;
}

struct Args {
    const float* in[19];
    float* out; unsigned char* ws;
    int ph_lo, ph_hi;
};

__device__ __forceinline__ int cin_row(int n) { if (n < 1024) return n; if (n < 2048) { const int c = n - 1024; return 1024 + (c >> 7) * 256 + (c & 127); } const int c = n - 2048; return 1024 + (c >> 7) * 256 + 128 + (c & 127); }
__device__ __forceinline__ void transpose_item(const float* __restrict__ W, int K, int N, bf16* __restrict__ WT, const float* __restrict__ gk, int mode, LAS float* scr, int item, int lane) {
    const int nblk = N / 32, kb = item / nblk, nb = item % nblk, k0 = 64 * kb, n0 = 32 * nb;
#pragma unroll 8
    for (int i = 0; i < 32; ++i) { const int kk = 2 * i + (lane >> 5); float v = W[(size_t)(k0 + kk) * N + n0 + (lane & 31)]; if (gk) v *= gk[k0 + kk]; scr[kk * 33 + (lane & 31)] = v; }
    asm volatile("s_waitcnt lgkmcnt(0)" ::: "memory");
    const int c = lane & 7;
    const int r0 = mode ? cin_row(n0) : n0;
#pragma unroll
    for (int j = 0; j < 4; ++j) { const int n = (lane >> 3) + 8 * j; const LAS float* s = scr + (8 * c) * 33 + n;
        v4u o; o.x = pk2(s[0 * 33], s[1 * 33]); o.y = pk2(s[2 * 33], s[3 * 33]); o.z = pk2(s[4 * 33], s[5 * 33]); o.w = pk2(s[6 * 33], s[7 * 33]);
        *(v4u*)(WT + (size_t)(r0 + n) * K + k0 + 8 * c) = o; }
    asm volatile("s_waitcnt lgkmcnt(0)" ::: "memory");
}

__device__ __forceinline__ int t5_bucket(int rel) {
    const int n = rel < 0 ? -rel : rel; int b;
    if (n < 8) b = n; else { b = 8 + (n >= 12) + (n >= 16) + (n >= 23) + (n >= 32) + (n >= 46) + (n >= 64) + (n >= 91); if (b > 15) b = 15; }
    return (rel > 0 ? 16 : 0) + b;
}

__global__ void __launch_bounds__(NWAVES * 64, 2) fwd_kernel(Args a) {
    extern __shared__ __attribute__((aligned(16))) unsigned char lds_raw[];
    LAS unsigned char* lds = (LAS unsigned char*)lds_raw;
    cg::grid_group grid = cg::this_grid();
    const int G = gridDim.x, bx = blockIdx.x;
    const int NGW = G * NWAVES, NGT = G * NWAVES * 64;
#define TID_LOCALS() int tid_ = threadIdx.x; asm volatile("" : "+v"(tid_)); const int tid = tid_, lane = tid & 63, wave = __builtin_amdgcn_readfirstlane(tid >> 6), gw = bx * NWAVES + wave, gt = bx * (NWAVES * 64) + tid; (void)lane; (void)gw; (void)gt;
    unsigned char* ws = a.ws;
    const float* x_prompt = a.in[0]; const float* x_sample = a.in[1]; const float* p_prompt = a.in[2]; const float* p_sample = a.in[3];
    const float* rel_bias = a.in[4]; const float* attn_w_qkv = a.in[5]; const float* attn_w_o = a.in[6]; const float* attn_sink = a.in[7];
    const float* conv_w_in = a.in[8]; const float* conv_w = a.in[9]; const float* conv_w_out = a.in[10]; const float* mlp_w_up = a.in[11];
    const float* mlp_w_down = a.in[12]; const float* ple_w_gate = a.in[13]; const float* ple_w_proj = a.in[14];
    const float* norm_mix = a.in[15]; const float* norm_mlp = a.in[16]; const float* norm_ple = a.in[17]; const float* final_norm = a.in[18];
    float* out = a.out;
    float* biasg = (float*)(ws + WS_BIAS); float* sink2 = (float*)(ws + WS_SINK); float* SS = (float*)(ws + WS_SS);
    bf16* Wb = (bf16*)(ws + WS_W); bf16* XBm = (bf16*)(ws + WS_XB); bf16* PB = (bf16*)(ws + WS_PB);
    bf16* S0 = (bf16*)(ws + WS_H); bf16* S2 = (bf16*)(ws + WS_H + 2 * SLOT); bf16* S3 = (bf16*)(ws + WS_H + 3 * SLOT);
    const int lo = a.ph_lo, hi = a.ph_hi;
    int ph = 0;
#define IN_PH() (lo <= ph && ph < hi)
#define SEAM() do { if (lo <= ph && ph + 1 < hi) { asm volatile("s_waitcnt vmcnt(0) lgkmcnt(0)" ::: "memory"); grid.sync(); __builtin_amdgcn_fence(__ATOMIC_ACQUIRE, "agent"); asm volatile("s_waitcnt vmcnt(0)" ::: "memory"); } ++ph; } while (0)

    if (IN_PH()) {
        TID_LOCALS();
        LAS float* scr = (LAS float*)(lds + wave * 16384);
        constexpr int I_QKV = 16 * 48, I_CIN = 16 * 96, I_SQ = 16 * 32, I_UP = 16 * 128, I_DN = 64 * 32, I_P = 4 * 32;
        constexpr int L_EVEN = I_QKV + I_SQ + I_UP + I_DN + I_SQ + I_P, L_ODD = I_CIN + I_SQ + I_UP + I_DN + I_SQ + I_P;
        constexpr int NITEMS = 2 * (L_EVEN + L_ODD);
        for (int it = gw; it < NITEMS; it += NGW) {
            int r = it; const int pair = r / (L_EVEN + L_ODD); r -= pair * (L_EVEN + L_ODD);
            int i = 2 * pair; if (r >= L_EVEN) { r -= L_EVEN; i += 1; }
            const int j = pair; const bool odd = i & 1;
            const int I_IN = odd ? I_CIN : I_QKV;
            if (r < I_IN) {
                if (odd) transpose_item(conv_w_in + (size_t)j * D * NCIN, D, NCIN, Wb + W_CIN + (size_t)j * NCIN * D, norm_mix + i * D, 1, scr, r, lane);
                else transpose_item(attn_w_qkv + (size_t)j * D * NQKV, D, NQKV, Wb + W_QKV + (size_t)j * NQKV * D, norm_mix + i * D, 0, scr, r, lane);
                continue; }
            r -= I_IN;
            if (r < I_SQ) {
                if (odd) transpose_item(conv_w_out + (size_t)j * D * D, D, D, Wb + W_COUT + (size_t)j * D * D, nullptr, 0, scr, r, lane);
                else transpose_item(attn_w_o + (size_t)j * D * D, D, D, Wb + W_O + (size_t)j * D * D, nullptr, 0, scr, r, lane);
                continue; }
            r -= I_SQ;
            if (r < I_UP) { transpose_item(mlp_w_up + (size_t)i * D * FF, D, FF, Wb + W_UP + (size_t)i * FF * D, norm_mlp + i * D, 0, scr, r, lane); continue; }
            r -= I_UP;
            if (r < I_DN) { transpose_item(mlp_w_down + (size_t)i * FF * D, FF, D, Wb + W_DN + (size_t)i * D * FF, nullptr, 0, scr, r, lane); continue; }
            r -= I_DN;
            if (r < I_SQ) { transpose_item(ple_w_gate + (size_t)i * D * D, D, D, Wb + W_G + (size_t)i * D * D, norm_ple + i * D, 0, scr, r, lane); continue; }
            r -= I_SQ;
            transpose_item(ple_w_proj + (size_t)i * PLE * D, PLE, D, Wb + W_P + (size_t)i * D * PLE, nullptr, 0, scr, r, lane);
        }
        for (int m = gw; m < M; m += NGW) {
            const float* xr = (m < MP) ? x_prompt + (size_t)m * D : x_sample + (size_t)(m - MP) * D;
            const f32x4* x4 = (const f32x4*)xr + lane; float s = 0.f; f32x4 v[4];
#pragma unroll
            for (int j = 0; j < 4; ++j) { v[j] = x4[64 * j]; s += (v[j].x * v[j].x + v[j].y * v[j].y) + (v[j].z * v[j].z + v[j].w * v[j].w); }
            s = wave_sum(s);
            v2u* o8 = (v2u*)(S3 + (size_t)m * D) + lane;
#pragma unroll
            for (int j = 0; j < 4; ++j) { v2u w; w.x = pk2(v[j].x, v[j].y); w.y = pk2(v[j].z, v[j].w); o8[64 * j] = w; }
            if (lane < 16) SS[(size_t)m * 16 + lane] = (lane == 0) ? s : 0.f;
        }
        for (int i = gt; i < 16 * 320; i += NGT) {
            const int h = i / 320, e = i % 320, t = e - 32; float v = 0.f;
            if (t >= 0 && t <= 256) v = rel_bias[t5_bucket(t - 128) * 16 + h] * 1.4426950408889634f;
            biasg[i] = v;
        }
        if (gt < 32) sink2[gt] = attn_sink[gt] * 1.4426950408889634f;
    }
    SEAM();

#pragma unroll 1
    for (int i = 0; i < DEPTH; ++i) {
        const int j = i >> 1; const bool odd = i & 1;
        if (IN_PH()) {
            TID_LOCALS();
            const float* pp = p_prompt + (size_t)i * MP * PLE; const float* ps = p_sample + (size_t)i * MS * PLE;
            for (int c = gt; c < M * PLE / 8; c += NGT) {
                const size_t e = (size_t)c * 8;
                const float* src = (e < (size_t)MP * PLE) ? pp + e : ps + (e - (size_t)MP * PLE);
                const f32x4 a0 = *(const f32x4*)src, a1 = *(const f32x4*)(src + 4);
                v4u w; w.x = pk2(a0.x, a0.y); w.y = pk2(a0.z, a0.w); w.z = pk2(a1.x, a1.y); w.w = pk2(a1.z, a1.w);
                *(v4u*)(PB + e) = w;
            }
            if (!odd) {
                pg8::Gemm g{S3, Wb + W_QKV + (size_t)j * NQKV * D, M, NQKV, D}; pg8::StaticOrder S; S.init(M, NQKV, G, bx);
                pg8::EpiBf16R<1> E{S0, NQKV, SS + (size_t)((3 * i) & 1) * M * 16};
#ifndef NO_QKV
                pg8::gemm_phase<pg8::EpiBf16R<1>, pg8::StaticOrder, true, true>(lds, g, S, E);
#endif
            } else {
                pg8::Gemm g{S3, Wb + W_CIN + (size_t)j * NCIN * D, M, NCIN, D}; pg8::StaticOrder S; S.init(M, NCIN, G, bx);
                pg8::EpiBf16R<3> E{S0, 2048, SS + (size_t)((3 * i) & 1) * M * 16};
#ifndef NO_CIN
                pg8::gemm_phase<pg8::EpiBf16R<3>, pg8::StaticOrder, true, true>(lds, g, S, E);
#endif
            }
        }
        SEAM();
        if (IN_PH()) {
            TID_LOCALS();
            if (!odd) {
                for (int u = bx; u < 640 * 4; u += G) {
                    const int sb = u >> 2, g = u & 3; int rowbase, q0, S;
                    if (sb < 512) { rowbase = (sb >> 5) * SEQ_P; q0 = (sb & 31) * 128; S = SEQ_P; }
                    else { const int t = sb - 512; rowbase = MP + (t >> 4) * SEQ_S; q0 = (t & 15) * 128; S = SEQ_S; }
#ifndef NO_ATTN
                    attn::attn_unit(lds, S0, S2, biasg, sink2 + j * 16, rowbase, q0, S, g);
#endif
                }
            } else {
                const float* cw = conv_w + (size_t)j * 3 * D;
                for (int c = gt; c < M * (D / 8); c += NGT) {
                    const int row = c >> 7, c8 = (c & 127) * 8;
                    const int pos = (row < MP) ? (row & (SEQ_P - 1)) : ((row - MP) & (SEQ_S - 1));
                    const int Sq = (row < MP) ? SEQ_P : SEQ_S;
                    const bf16* bz = S0 + (size_t)row * 2048;
                    const v4u bb = *(const v4u*)(bz + c8), zc = *(const v4u*)(bz + 1024 + c8);
                    v4u zm = (v4u){0u, 0u, 0u, 0u}, zp = (v4u){0u, 0u, 0u, 0u};
                    if (pos > 0) zm = *(const v4u*)(bz - 2048 + 1024 + c8);
                    if (pos < Sq - 1) zp = *(const v4u*)(bz + 2048 + 1024 + c8);
                    const f32x4 w0a = *(const f32x4*)(cw + c8), w0b = *(const f32x4*)(cw + c8 + 4), w1a = *(const f32x4*)(cw + D + c8), w1b = *(const f32x4*)(cw + D + c8 + 4),
                                w2a = *(const f32x4*)(cw + 2 * D + c8), w2b = *(const f32x4*)(cw + 2 * D + c8 + 4);
                    float r[8];
#define CV(e, W0, W1, W2, ZM, ZC, ZP, BB, LOHI) r[e] = LOHI(BB) * (W0 * LOHI(ZM) + W1 * LOHI(ZC) + W2 * LOHI(ZP))
                    CV(0, w0a.x, w1a.x, w2a.x, zm.x, zc.x, zp.x, bb.x, pg8::bf_lo); CV(1, w0a.y, w1a.y, w2a.y, zm.x, zc.x, zp.x, bb.x, pg8::bf_hi);
                    CV(2, w0a.z, w1a.z, w2a.z, zm.y, zc.y, zp.y, bb.y, pg8::bf_lo); CV(3, w0a.w, w1a.w, w2a.w, zm.y, zc.y, zp.y, bb.y, pg8::bf_hi);
                    CV(4, w0b.x, w1b.x, w2b.x, zm.z, zc.z, zp.z, bb.z, pg8::bf_lo); CV(5, w0b.y, w1b.y, w2b.y, zm.z, zc.z, zp.z, bb.z, pg8::bf_hi);
                    CV(6, w0b.z, w1b.z, w2b.z, zm.w, zc.w, zp.w, bb.w, pg8::bf_lo); CV(7, w0b.w, w1b.w, w2b.w, zm.w, zc.w, zp.w, bb.w, pg8::bf_hi);
#undef CV
                    v4u w; w.x = pk2(r[0], r[1]); w.y = pk2(r[2], r[3]); w.z = pk2(r[4], r[5]); w.w = pk2(r[6], r[7]);
                    *(v4u*)(S2 + (size_t)row * D + c8) = w;
                }
            }
        }
        SEAM();
        if (IN_PH()) {
            pg8::Gemm g{S2, odd ? Wb + W_COUT + (size_t)j * D * D : Wb + W_O + (size_t)j * D * D, M, D, D}; pg8::StaticOrder S; S.init(M, D, G, bx);
            pg8::EpiResid<0> E{S3, XBm, SS + (size_t)((3 * i + 1) & 1) * M * 16, nullptr, nullptr};
#ifndef NO_MIXOUT
            pg8::gemm_phase<pg8::EpiResid<0>, pg8::StaticOrder, true, true>(lds, g, S, E);
#endif
        }
        SEAM();
        if (IN_PH()) {
            pg8::Gemm g{XBm, Wb + W_UP + (size_t)i * FF * D, M, FF, D}; pg8::StaticOrder S; S.init(M, FF, G, bx);
            pg8::EpiBf16R<2> E{S0, FF, SS + (size_t)((3 * i + 1) & 1) * M * 16};
#ifndef NO_UP
            pg8::gemm_phase<pg8::EpiBf16R<2>, pg8::StaticOrder, true, true>(lds, g, S, E);
#endif
        }
        SEAM();
        if (IN_PH()) {
            pg8::Gemm g{S0, Wb + W_DN + (size_t)i * D * FF, M, D, FF}; pg8::StaticOrder S; S.init(M, D, G, bx);
            pg8::EpiResid<0> E{XBm, XBm, SS + (size_t)((3 * i + 2) & 1) * M * 16, nullptr, nullptr};
#ifndef NO_DOWN
            pg8::gemm_phase<pg8::EpiResid<0>, pg8::StaticOrder, true, true>(lds, g, S, E);
#endif
        }
        SEAM();
        if (IN_PH()) {
            {
                pg8::Gemm g{PB, Wb + W_P + (size_t)i * D * PLE, M, D, PLE}; pg8::StaticOrder S; S.init(M, D, G, bx);
                pg8::EpiBf16R<0> E{S0, D, nullptr};
#ifndef NO_PROJ
                pg8::gemm_phase<pg8::EpiBf16R<0>, pg8::StaticOrder, true, true>(lds, g, S, E);
#endif
            }
            {
                pg8::Gemm g{XBm, Wb + W_G + (size_t)i * D * D, M, D, D}; pg8::StaticOrder S; S.init(M, D, G, bx);
                pg8::EpiResid<1> E{XBm, S3, SS + (size_t)((3 * i + 3) & 1) * M * 16, SS + (size_t)((3 * i + 2) & 1) * M * 16, S0};
#ifndef NO_GATE
                pg8::gemm_phase<pg8::EpiResid<1>, pg8::StaticOrder, true, true>(lds, g, S, E);
#endif
            }
        }
        SEAM();
    }
    if (IN_PH()) {
        TID_LOCALS();
        const float* ssf = SS;
        for (int m = gw; m < M; m += NGW) {
            const float rs = pg8::rinv_of(ssf, m);
            f32x4* o4 = (f32x4*)(out + (size_t)m * D) + lane; const f32x4* g4 = (const f32x4*)final_norm + lane; const v2u* xb = (const v2u*)(S3 + (size_t)m * D) + lane;
#pragma unroll
            for (int q = 0; q < 4; ++q) { const v2u w = xb[64 * q]; const f32x4 gg = g4[64 * q]; f32x4 v; v.x = pg8::bf_lo(w.x); v.y = pg8::bf_hi(w.x); v.z = pg8::bf_lo(w.y); v.w = pg8::bf_hi(w.y); o4[64 * q] = v * rs * gg; }
        }
    }
#undef IN_PH
#undef SEAM
}

constexpr int N_PHASES = 1 + 6 * DEPTH + 1;
extern "C" void kernel_launch(void* const* d_in, const int* in_sizes, int n_in, void* d_out, int out_size, void* d_ws, size_t ws_size, hipStream_t stream) {
    static int grid = 0;
    if (grid == 0) {
        if (n_in != 19 || out_size != M * D || ws_size < WS_END) { fprintf(stderr, "kernel_launch: unexpected shapes (n_in %d out %d ws %zu need %zu)\n", n_in, out_size, ws_size, (size_t)WS_END); grid = -1; return; }
        int dev = 0, cus = 0, per_cu = 0;
        hipGetDevice(&dev); hipDeviceGetAttribute(&cus, hipDeviceAttributeMultiprocessorCount, dev);
        if (hipFuncSetAttribute((const void*)fwd_kernel, hipFuncAttributeMaxDynamicSharedMemorySize, LDS_BYTES) != hipSuccess) { fprintf(stderr, "hipFuncSetAttribute failed\n"); grid = -1; return; }
        if (hipOccupancyMaxActiveBlocksPerMultiprocessor(&per_cu, (const void*)fwd_kernel, NWAVES * 64, LDS_BYTES) != hipSuccess || per_cu < 1) { fprintf(stderr, "occupancy query failed (%d)\n", per_cu); per_cu = 1; (void)hipGetLastError(); }
        grid = cus * per_cu;
    }
    if (grid < 0) return;
    Args a{};
    for (int i = 0; i < 19; ++i) a.in[i] = (const float*)d_in[i];
    a.out = (float*)d_out; a.ws = (unsigned char*)d_ws;
#if defined(MK_MULTI)
    for (int p = 0; p < N_PHASES; ++p) { a.ph_lo = p; a.ph_hi = p + 1; hipLaunchKernelGGL(fwd_kernel, dim3(grid), dim3(NWAVES * 64), LDS_BYTES, stream, a); }
#else
    a.ph_lo = 0; a.ph_hi = N_PHASES;
    void* args[] = {&a};
    hipError_t e = hipLaunchCooperativeKernel((const void*)fwd_kernel, dim3(grid), dim3(NWAVES * 64), args, LDS_BYTES, stream);
    if (e != hipSuccess) fprintf(stderr, "cooperative launch failed: %s (grid %d)\n", hipGetErrorString(e), grid);
#endif
}
```

```cpp
#include <hip/hip_runtime.h>
#include <hip/hip_cooperative_groups.h>
#include <cstdio>
#include <cstdint>
namespace cg = cooperative_groups;
__device__ __forceinline__ float xl32_add(float s) { const auto r = __builtin_amdgcn_permlane32_swap(__float_as_uint(s), __float_as_uint(s), false, false); return __uint_as_float(r[0]) + __uint_as_float(r[1]); }
__device__ __forceinline__ float xl16_add(float s) { const auto r = __builtin_amdgcn_permlane16_swap(__float_as_uint(s), __float_as_uint(s), false, false); return __uint_as_float(r[0]) + __uint_as_float(r[1]); }
__device__ __forceinline__ float xl32_max(float s) { const auto r = __builtin_amdgcn_permlane32_swap(__float_as_uint(s), __float_as_uint(s), false, false); return __builtin_fmaxf(__uint_as_float(r[0]), __uint_as_float(r[1])); }
namespace pg8 {
#define PG8_LAS __attribute__((address_space(3)))
typedef unsigned short bf16_t;
typedef short bf16x8 __attribute__((ext_vector_type(8)));
typedef float f32x4 __attribute__((ext_vector_type(4)));
typedef unsigned u32x4 __attribute__((ext_vector_type(4)));
constexpr int BM = 256, BK = 64, HALF = 128, HTB = HALF * BK * 2  , STAGE_BYTES = 8 * HTB, NXCD = 8, WGM = 8;

__host__ __device__ __forceinline__ int lds_byte(int r, int c) { const int st = (r >> 4) * 2 + (c >> 5), rr = r & 15, cc = c & 31, ob = rr * 64 + cc * 2; return st * 1024 + (ob ^ (((ob >> 9) & 1) << 5)); }
__host__ __device__ __forceinline__ void stage_rc(int b, int& R, int& C) { const int st = b / 1024, sb = b % 1024, swz = sb ^ (((sb >> 9) & 1) << 5); R = (st >> 1) * 16 + swz / 64; C = (st & 1) * 32 + (swz % 64) / 2; }
__host__ __device__ __forceinline__ int perm32(int rho) { const int n = rho >> 4, i = rho & 15; return 8 * (i >> 2) + 4 * n + (i & 3); }

struct Unit { int pm, pn; };
struct Gemm { const bf16_t* A; const bf16_t* Bt; int M, N, K; };

struct StaticOrder {
    int nM, nN, nwg, G, c, rev;
    __host__ __device__ void init(int M, int N, int G_, int c_) { nM = M / BM; nN = N / BM; nwg = nM * nN; G = G_; c = c_; rev = 0; }
    __host__ __device__ void reverse() { rev = (nwg % G == 0) ? nwg / G : 0; }
    __host__ __device__ bool next(int i, Unit& u) const {
        if (rev) { if (i >= rev) return false; i = rev - 1 - i; }
        const long L = (long)i * G + c; if (L >= nwg) return false;
        int wgid = (int)L; { const int q = nwg / NXCD, r = nwg % NXCD, xcd = wgid % NXCD, off = wgid / NXCD; wgid = (xcd < r ? xcd * (q + 1) : r * (q + 1) + (xcd - r) * q) + off; }
        const int nig = WGM * nN, gid = wgid / nig, fm = gid * WGM, gsz = (nM - fm) < WGM ? (nM - fm) : WGM;
        u.pm = fm + ((wgid % nig) % gsz); u.pn = (wgid % nig) / gsz; return true;
    }
    __device__ __forceinline__ void a_ready(const Unit&) const {}
    __device__ __forceinline__ void done(const Unit&) const {}
};

__device__ __forceinline__ unsigned cvt_pk_bf16(float lo, float hi) { unsigned r; asm volatile("v_cvt_pk_bf16_f32 %0, %1, %2" : "=v"(r) : "v"(lo), "v"(hi)); return r; }
typedef float f32x2 __attribute__((ext_vector_type(2)));
template <class Epi, class Sched, bool ALIGN_EPI = false, bool SP2 = false>
__device__ __forceinline__ void gemm_phase(PG8_LAS unsigned char* lds, const Gemm g, const Sched& S, const Epi& E) {
    int tid_ = threadIdx.x; asm volatile("" : "+v"(tid_));
    const int tid = tid_, wid = __builtin_amdgcn_readfirstlane(tid >> 6), lane = tid & 63, wr = wid >> 2, wc = wid & 3, fr = lane & 15, fq = lane >> 4;
    int K_ = g.K; asm volatile("" : "+s"(K_));
    const int K = K_, nt = K / BK;
    unsigned voffA[2], voffB[2];
#pragma unroll
    for (int i = 0; i < 2; ++i) { int R, C; stage_rc(tid * 16 + i * 8192, R, C); const int Rb = Epi::PERM ? ((R & ~31) + perm32(R & 31)) : R;
        voffA[i] = (unsigned)(R * K + C) * 2u; voffB[i] = (unsigned)(Rb * K + C) * 2u; }
    const size_t kstep = (size_t)(BK * 2);
    const size_t hstep = (size_t)HALF * K * 2;
    const size_t tstep = 2 * hstep;
    const unsigned ldsw = (unsigned)wid * 1024u;
    const int aoff = lds_byte(wr * 64 + fr, fq * 8), boff = lds_byte(wc * 32 + fr, fq * 8);
#define PG8_SA(b, h) (((b) * 2 + (h)) * HTB)
#define PG8_SB(b, h) ((4 + (b) * 2 + (h)) * HTB)
#define PG8_STAGE(bufoff, gbase, voff) do { _Pragma("unroll") for (int _i = 0; _i < 2; ++_i) \
        __builtin_amdgcn_global_load_lds((const unsigned*)((const char*)(gbase) + (voff)[_i]), (PG8_LAS unsigned*)(lds + (bufoff) + ldsw + _i * 8192), 16, 0, 0); } while (0)
#define PG8_LDA(dst, b, h) do { _Pragma("unroll") for (int m = 0; m < 4; ++m) _Pragma("unroll") for (int k = 0; k < 2; ++k) dst[m][k] = *(const PG8_LAS bf16x8*)(lds + PG8_SA(b, h) + aoff + m * 2048 + k * 1024); } while (0)
#define PG8_LDB(dst, b, h) do { _Pragma("unroll") for (int n = 0; n < 2; ++n) _Pragma("unroll") for (int k = 0; k < 2; ++k) dst[n][k] = *(const PG8_LAS bf16x8*)(lds + PG8_SB(b, h) + boff + n * 2048 + k * 1024); } while (0)
#define PG8_MMA(ai, bj, At, Bt) do { __builtin_amdgcn_s_setprio(1); _Pragma("unroll") for (int m = 0; m < 4; ++m) _Pragma("unroll") for (int n = 0; n < 2; ++n) _Pragma("unroll") for (int k = 0; k < 2; ++k) \
        acc[ai][bj][m][n] = __builtin_amdgcn_mfma_f32_16x16x32_bf16(Bt[n][k], At[m][k], acc[ai][bj][m][n], 0, 0, 0); __builtin_amdgcn_s_setprio(0); } while (0)
#define PG8_WAIT_V(n) asm volatile("s_waitcnt vmcnt(" #n ")" ::: "memory")
#define PG8_WAIT_L(n) asm volatile("s_waitcnt lgkmcnt(" #n ")" ::: "memory")
#define PG8_BAR __builtin_amdgcn_s_barrier()
#define PG8_SCHED __builtin_amdgcn_sched_barrier(0)
    Unit cur, nxt; int ui = 0;
    if (!S.next(0, cur)) return;
    f32x4 acc[2][2][4][2];
#pragma unroll
    for (int a = 0; a < 2; ++a)
#pragma unroll
        for (int b = 0; b < 2; ++b)
#pragma unroll
            for (int m = 0; m < 4; ++m)
#pragma unroll
                for (int n = 0; n < 2; ++n) acc[a][b][m][n] = (f32x4){0.f, 0.f, 0.f, 0.f};
    bf16x8 At[4][2], B0[2][2], B1[2][2];
    const char* cA = (const char*)g.A + (size_t)cur.pm * tstep; const char* cB = (const char*)g.Bt + (size_t)cur.pn * tstep;
    S.a_ready(cur);
    if constexpr (SP2) {
        PG8_STAGE(PG8_SB(0, 0), cB, voffB); PG8_STAGE(PG8_SB(0, 1), cB + hstep, voffB); PG8_STAGE(PG8_SA(0, 0), cA, voffA); PG8_STAGE(PG8_SA(0, 1), cA + hstep, voffA);
        if (wr == 1) PG8_BAR;
        PG8_WAIT_V(2); PG8_BAR;
        PG8_STAGE(PG8_SB(1, 0), cB + kstep, voffB); PG8_STAGE(PG8_SA(1, 0), cA + kstep, voffA); PG8_STAGE(PG8_SB(1, 1), cB + hstep + kstep, voffB);
        PG8_WAIT_V(6); PG8_BAR;
    } else {
        PG8_STAGE(PG8_SB(0, 0), cB, voffB); PG8_STAGE(PG8_SA(0, 0), cA, voffA); PG8_STAGE(PG8_SB(0, 1), cB + hstep, voffB); PG8_STAGE(PG8_SA(0, 1), cA + hstep, voffA);
        if (wr == 1) PG8_BAR;
        PG8_WAIT_V(4); PG8_BAR;
        PG8_STAGE(PG8_SB(1, 0), cB + kstep, voffB); PG8_STAGE(PG8_SA(1, 0), cA + kstep, voffA); PG8_STAGE(PG8_SB(1, 1), cB + hstep + kstep, voffB);
        PG8_WAIT_V(6); PG8_BAR;
    }
    for (;;) {
        const bool has_next = S.next(ui + 1, nxt);
        const char* nA = has_next ? (const char*)g.A + (size_t)nxt.pm * tstep : cA; const char* nB = has_next ? (const char*)g.Bt + (size_t)nxt.pn * tstep : cB;
        for (int t = 0; t < nt; t += 2) {
            const bool last = (t == nt - 2);
            const char* a1 = cA + (size_t)(t + 1) * kstep;
            const char* a2 = last ? nA : cA + (size_t)(t + 2) * kstep; const char* b2 = last ? nB : cB + (size_t)(t + 2) * kstep;
            const char* a3 = a2 + kstep; const char* b3 = b2 + kstep;
            if (last && has_next) S.a_ready(nxt);
            if constexpr (SP2) {
            PG8_LDB(B0, 0, 0); PG8_LDB(B1, 0, 1); PG8_SCHED; PG8_LDA(At, 0, 0); PG8_STAGE(PG8_SA(1, 1), a1 + hstep, voffA);
            PG8_WAIT_V(8); PG8_WAIT_L(0); PG8_BAR; PG8_MMA(0, 0, At, B0); PG8_MMA(0, 1, At, B1); PG8_BAR; PG8_SCHED;
            PG8_LDA(At, 0, 1); PG8_STAGE(PG8_SB(0, 0), b2, voffB); PG8_STAGE(PG8_SB(0, 1), b2 + hstep, voffB); PG8_STAGE(PG8_SA(0, 0), a2, voffA);
            PG8_WAIT_V(8); PG8_WAIT_L(0); PG8_BAR; PG8_MMA(1, 0, At, B0); PG8_MMA(1, 1, At, B1); PG8_BAR; PG8_SCHED;
            PG8_LDB(B0, 1, 0); PG8_LDB(B1, 1, 1); PG8_SCHED; PG8_LDA(At, 1, 0); PG8_STAGE(PG8_SA(0, 1), a2 + hstep, voffA);
            PG8_WAIT_V(8); PG8_WAIT_L(0); PG8_BAR; PG8_MMA(0, 0, At, B0); PG8_MMA(0, 1, At, B1); PG8_BAR; PG8_SCHED;
            PG8_LDA(At, 1, 1); PG8_STAGE(PG8_SB(1, 0), b3, voffB); PG8_STAGE(PG8_SB(1, 1), b3 + hstep, voffB); PG8_STAGE(PG8_SA(1, 0), a3, voffA);
            PG8_WAIT_V(8); PG8_WAIT_L(0); PG8_BAR; PG8_MMA(1, 0, At, B0); PG8_MMA(1, 1, At, B1); PG8_BAR; PG8_SCHED;
            } else {
            PG8_LDB(B0, 0, 0); PG8_SCHED; PG8_LDA(At, 0, 0); PG8_STAGE(PG8_SA(1, 1), a1 + hstep, voffA);
            PG8_WAIT_L(8); PG8_BAR; PG8_WAIT_L(0); PG8_MMA(0, 0, At, B0); PG8_BAR; PG8_SCHED;
            PG8_LDB(B1, 0, 1); PG8_STAGE(PG8_SB(0, 0), b2, voffB);
            PG8_BAR; PG8_WAIT_L(0); PG8_MMA(0, 1, At, B1); PG8_BAR;
            PG8_LDA(At, 0, 1); PG8_STAGE(PG8_SA(0, 0), a2, voffA);
            PG8_BAR; PG8_WAIT_L(0); PG8_MMA(1, 0, At, B0); PG8_BAR; PG8_SCHED;
            PG8_STAGE(PG8_SB(0, 1), b2 + hstep, voffB);
            PG8_WAIT_V(6); PG8_BAR; PG8_MMA(1, 1, At, B1); PG8_BAR;
            PG8_LDB(B0, 1, 0); PG8_SCHED; PG8_LDA(At, 1, 0); PG8_STAGE(PG8_SA(0, 1), a2 + hstep, voffA);
            PG8_WAIT_L(8); PG8_BAR; PG8_WAIT_L(0); PG8_MMA(0, 0, At, B0); PG8_BAR; PG8_SCHED;
            PG8_LDB(B1, 1, 1); PG8_STAGE(PG8_SB(1, 0), b3, voffB);
            PG8_BAR; PG8_WAIT_L(0); PG8_MMA(0, 1, At, B1); PG8_BAR;
            PG8_LDA(At, 1, 1); PG8_STAGE(PG8_SA(1, 0), a3, voffA);
            PG8_BAR; PG8_WAIT_L(0); PG8_MMA(1, 0, At, B0); PG8_BAR; PG8_SCHED;
            PG8_STAGE(PG8_SB(1, 1), b3 + hstep, voffB);
            PG8_WAIT_V(6); PG8_BAR; PG8_MMA(1, 1, At, B1); PG8_BAR;
            }
        }
        if constexpr (ALIGN_EPI) { if (wr == 0) PG8_BAR; }
        if constexpr (!Epi::AFTER_DRAIN) { E(acc, cur, wr, wc, fr, fq);
#if defined(EPI_REPS)
            if constexpr (Epi::IDEMP) { _Pragma("unroll 1") for (int rep_ = 1; rep_ < EPI_REPS; ++rep_) { asm volatile("" ::: "memory"); E(acc, cur, wr, wc, fr, fq); } }
#endif
            S.done(cur); }
        if (!has_next) break;
#pragma unroll
        for (int a = 0; a < 2; ++a)
#pragma unroll
            for (int b = 0; b < 2; ++b)
#pragma unroll
                for (int m = 0; m < 4; ++m)
#pragma unroll
                    for (int n = 0; n < 2; ++n) acc[a][b][m][n] = (f32x4){0.f, 0.f, 0.f, 0.f};
        cur = nxt; cA = nA; cB = nB; ++ui;
        if constexpr (ALIGN_EPI) { if (wr == 1) PG8_BAR; }
    }
    PG8_WAIT_V(0);
    if constexpr (!ALIGN_EPI) { if (wr == 0) PG8_BAR; }
    PG8_BAR;
    if constexpr (Epi::AFTER_DRAIN) { E.fused(acc, cur, wr, wc, fr, fq, lds, wid, lane); S.done(cur); }
#undef PG8_SA
#undef PG8_SB
#undef PG8_STAGE
#undef PG8_LDA
#undef PG8_LDB
#undef PG8_MMA
#undef PG8_WAIT_V
#undef PG8_WAIT_L
#undef PG8_BAR
#undef PG8_SCHED
}
}
namespace pg8 {
constexpr float QSCALE = 0.125f * 1.4426950408889634f;
constexpr float RMS_EPS = 1e-6f;
constexpr int MP_ROWS = 65536;
__device__ __forceinline__ float ss_sum(const float* ss, int row, int fq) { const f32x4 a = *(const f32x4*)(ss + (size_t)row * 16 + 4 * fq);
    float s = (a[0] + a[1]) + (a[2] + a[3]); s = xl16_add(s); s = xl32_add(s); return s; }
__device__ __forceinline__ f32x4 ss_load(const float* ss, int row, int fq) { return *(const f32x4*)(ss + (size_t)row * 16 + 4 * fq); }
__device__ __forceinline__ float rinv_from(const f32x4 a) { float s = (a[0] + a[1]) + (a[2] + a[3]); s = xl16_add(s); s = xl32_add(s); return __builtin_amdgcn_rsqf(s * (1.0f / 1024.0f) + RMS_EPS); }
#define SS_LOAD8(pa, ss, row0, fq) do { _Pragma("unroll") for (int i_ = 0; i_ < 8; ++i_) pa[i_] = ss_load(ss, (row0) + (i_ >> 2) * HALF + (i_ & 3) * 16, fq); \
    asm volatile("" : "+v"(pa[0]), "+v"(pa[1]), "+v"(pa[2]), "+v"(pa[3]), "+v"(pa[4]), "+v"(pa[5]), "+v"(pa[6]), "+v"(pa[7])); } while (0)
__device__ __forceinline__ float rinv_of(const float* ss, int row, int fq) { return __builtin_amdgcn_rsqf(ss_sum(ss, row, fq) * (1.0f / 1024.0f) + RMS_EPS); }
__device__ __forceinline__ float bf_lo(unsigned w) { return __uint_as_float(w << 16); }
__device__ __forceinline__ float bf_hi(unsigned w) { return __uint_as_float(w & 0xffff0000u); }

template <int MODE> struct EpiBf16R {
    static constexpr bool PERM = true, AFTER_DRAIN = false, IDEMP = true;
    bf16_t* O; int ldc; const float* ss;
    __device__ __forceinline__ void operator()(const f32x4 (&acc)[2][2][4][2], const Unit& u, int wr, int wc, int fr, int fq) const {
        const int row0 = u.pm * BM + wr * 64 + fr;
        const int colw = wc * 32 + 8 * fq;
        float sc = 1.f;
        if (MODE == 1) { if (u.pn < 4) sc = QSCALE; }
        float rsv[2][4];
        if (MODE != 0 && MODE != 2) {
            f32x4 pa[8]; SS_LOAD8(pa, ss, row0, fq);
#pragma unroll
            for (int i = 0; i < 8; ++i) rsv[i >> 2][i & 3] = sc * rinv_from(pa[i]);
        } else {
#pragma unroll
            for (int i = 0; i < 8; ++i) rsv[i >> 2][i & 3] = sc;
        }
#pragma unroll
        for (int ai = 0; ai < 2; ++ai)
#pragma unroll
            for (int m = 0; m < 4; ++m) {
                const int row = row0 + ai * HALF + m * 16;
                const float rs = rsv[ai][m];
                bf16_t* rowp = O + (size_t)row * ldc;
                if (MODE == 3 && u.pn >= 4) {
                    const f32x4 z0 = (acc[ai][0][m][0] * rs) * (acc[ai][1][m][0] * rs), z1 = (acc[ai][0][m][1] * rs) * (acc[ai][1][m][1] * rs);
                    u32x4 w; w.x = cvt_pk_bf16(z0[0], z0[1]); w.y = cvt_pk_bf16(z0[2], z0[3]); w.z = cvt_pk_bf16(z1[0], z1[1]); w.w = cvt_pk_bf16(z1[2], z1[3]);
                    *(u32x4*)(rowp + 1024 + (u.pn - 4) * HALF + colw) = w;
                } else {
#pragma unroll
                    for (int bj = 0; bj < 2; ++bj) {
                        f32x4 v0, v1;
                        if (MODE == 2) {
                            const f32x4 a0 = acc[ai][bj][m][0], a1 = acc[ai][bj][m][1]; f32x4 m0, m1;
#pragma unroll
                            for (int e = 0; e < 4; ++e) { m0[e] = fmaxf(a0[e], 0.f); m1[e] = fmaxf(a1[e], 0.f); }
                            v0 = a0 * m0; v1 = a1 * m1;
                        } else { v0 = acc[ai][bj][m][0] * rs; v1 = acc[ai][bj][m][1] * rs; }
                        u32x4 w; w.x = cvt_pk_bf16(v0[0], v0[1]); w.y = cvt_pk_bf16(v0[2], v0[3]); w.z = cvt_pk_bf16(v1[0], v1[1]); w.w = cvt_pk_bf16(v1[2], v1[3]);
                        *(u32x4*)(rowp + u.pn * BM + bj * HALF + colw) = w;
                    }
                }
            }
    }
};

template <int MODE> struct EpiResid {
    static constexpr bool PERM = true, AFTER_DRAIN = false, IDEMP = false;
    const bf16_t* xold; bf16_t* xnew; float* ss_next; const float* ss_cur; const bf16_t* T;
    __device__ __forceinline__ void operator()(const f32x4 (&acc)[2][2][4][2], const Unit& u, int wr, int wc, int fr, int fq) const {
        const int row0 = u.pm * BM + wr * 64 + fr;
        const int col0 = u.pn * BM + wc * 32 + 8 * fq;
        float rsv[2][4];
        if (MODE != 0) {
            f32x4 pa[8]; SS_LOAD8(pa, ss_cur, row0, fq);
#pragma unroll
            for (int i = 0; i < 8; ++i) { const float r = rinv_from(pa[i]); rsv[i >> 2][i & 3] = (MODE == 1) ? r * (-1.4426950408889634f) : r * r; }
        }
        constexpr int RB = (MODE == 1) ? 2 : 4;
#pragma unroll
        for (int g8 = 0; g8 < 8; g8 += RB) {
            u32x4 xo[RB][2], tt[RB][2];
#pragma unroll
            for (int k = 0; k < RB; ++k)
#pragma unroll
                for (int bj = 0; bj < 2; ++bj) { const int ai = (g8 + k) >> 2, m = (g8 + k) & 3; const size_t off = (size_t)(row0 + ai * HALF + m * 16) * 1024 + col0 + bj * HALF;
                    xo[k][bj] = *(const u32x4*)(xold + off); if (MODE == 1) tt[k][bj] = *(const u32x4*)(T + off); }
            if (RB == 4) asm volatile("" : "+v"(xo[0][0]), "+v"(xo[0][1]), "+v"(xo[1][0]), "+v"(xo[1][1]), "+v"(xo[RB - 2][0]), "+v"(xo[RB - 2][1]), "+v"(xo[RB - 1][0]), "+v"(xo[RB - 1][1]));
            else asm volatile("" : "+v"(xo[0][0]), "+v"(xo[0][1]), "+v"(xo[1][0]), "+v"(xo[1][1]), "+v"(tt[0][0]), "+v"(tt[0][1]), "+v"(tt[1][0]), "+v"(tt[1][1]));
#pragma unroll
            for (int k = 0; k < RB; ++k) {
                const int ai = (g8 + k) >> 2, m = (g8 + k) & 3;
                const int row = row0 + ai * HALF + m * 16;
                const size_t roff = (size_t)row * 1024 + col0;
                float sq = 0.f;
#pragma unroll
                for (int bj = 0; bj < 2; ++bj) {
                    const u32x4 xv = xo[k][bj];
                    f32x4 d0 = acc[ai][bj][m][0], d1 = acc[ai][bj][m][1];
                    if (MODE == 2) { d0 = d0 * rsv[ai][m]; d1 = d1 * rsv[ai][m]; }
                    if (MODE == 1) {
                        const float rs = rsv[ai][m];
                        const u32x4 t = tt[k][bj];
                        f32x4 t0, t1; t0[0] = bf_lo(t.x); t0[1] = bf_hi(t.x); t0[2] = bf_lo(t.y); t0[3] = bf_hi(t.y); t1[0] = bf_lo(t.z); t1[1] = bf_hi(t.z); t1[2] = bf_lo(t.w); t1[3] = bf_hi(t.w);
#pragma unroll
                        for (int e = 0; e < 4; ++e) {
                            d0[e] = t0[e] * __builtin_amdgcn_rcpf(1.0f + __builtin_amdgcn_exp2f(d0[e] * rs));
                            d1[e] = t1[e] * __builtin_amdgcn_rcpf(1.0f + __builtin_amdgcn_exp2f(d1[e] * rs));
                        }
                    }
                    f32x4 x0, x1; x0[0] = bf_lo(xv.x) + d0[0]; x0[1] = bf_hi(xv.x) + d0[1]; x0[2] = bf_lo(xv.y) + d0[2]; x0[3] = bf_hi(xv.y) + d0[3];
                    x1[0] = bf_lo(xv.z) + d1[0]; x1[1] = bf_hi(xv.z) + d1[1]; x1[2] = bf_lo(xv.w) + d1[2]; x1[3] = bf_hi(xv.w) + d1[3];
                    u32x4 w; w.x = cvt_pk_bf16(x0[0], x0[1]); w.y = cvt_pk_bf16(x0[2], x0[3]); w.z = cvt_pk_bf16(x1[0], x1[1]); w.w = cvt_pk_bf16(x1[2], x1[3]);
                    *(u32x4*)(xnew + roff + bj * HALF) = w;
                    sq += (x0[0] * x0[0] + x0[1] * x0[1]) + (x0[2] * x0[2] + x0[3] * x0[3]) + (x1[0] * x1[0] + x1[1] * x1[1]) + (x1[2] * x1[2] + x1[3] * x1[3]);
                }
                sq = xl16_add(sq); sq = xl32_add(sq);
                if (fq == 0) ss_next[(size_t)row * 16 + u.pn * 4 + wc] = sq;
            }
        }
    }
};
}
namespace attn {
#define ALAS __attribute__((address_space(3)))
typedef unsigned short bf16_t;
typedef short bf16x8 __attribute__((ext_vector_type(8)));
typedef short s16x4 __attribute__((ext_vector_type(4)));
typedef short v4i16_t __attribute__((ext_vector_type(4)));
typedef float f32x16 __attribute__((ext_vector_type(16)));
typedef unsigned u32x4 __attribute__((ext_vector_type(4)));
typedef unsigned u32x2 __attribute__((ext_vector_type(2)));
constexpr int QKV_LD = 1536, KOFF = 1024, VOFF = 1280, O_LD = 1024;
constexpr int BT_STRIDE = 320;
constexpr int LDS_K = 0, LDS_V = 49152, LDS_BT = 98304, LDS_BYTES = LDS_BT + 16 * BT_STRIDE * 4;
constexpr float THR = 8.0f;
__device__ __forceinline__ unsigned cvtpk(float lo, float hi) { unsigned r; asm volatile("v_cvt_pk_bf16_f32 %0, %1, %2" : "=v"(r) : "v"(lo), "v"(hi)); return r; }
__device__ __forceinline__ float max3f(float a, float b, float c) { return __builtin_fmaxf(__builtin_fmaxf(a, b), c); }

struct UnitPos { int rowbase, q0, S, g; };
__device__ __forceinline__ int slot_unit(int s, int stride, int nunits) {
    if ((stride & 7) || (nunits % stride)) return s;
    const int nk = nunits / stride, k0 = s / stride, b = s - k0 * stride, k = nk - 1 - k0;
    return (b & 7) * (nunits >> 3) + k * (stride >> 3) + (b >> 3);
}
__device__ __forceinline__ UnitPos unit_pos(int u) {
    UnitPos p; const int sb = u >> 2; p.g = u & 3;
    if (sb < 512) { p.rowbase = (sb >> 5) * 4096; p.q0 = (sb & 31) * 128; p.S = 4096; }
    else { const int t = sb - 512; p.rowbase = 65536 + (t >> 4) * 2048; p.q0 = (t & 15) * 128; p.S = 2048; }
    return p;
}
__device__ __forceinline__ void band_fetch(u32x4 (&kk)[6], const bf16_t* __restrict__ QKV, const UnitPos& P, int tid, int off) {
#pragma unroll
    for (int i = 0; i < 6; ++i) {
        const int chunk = tid + 512 * i, kvr = chunk >> 3, c = chunk & 7, pos = P.q0 - 128 + kvr;
        kk[i] = (u32x4){0u, 0u, 0u, 0u};
        if (pos >= 0 && pos < P.S) kk[i] = *(const u32x4*)(QKV + (size_t)(P.rowbase + pos) * QKV_LD + P.g * 64 + c * 8 + off);
    }
}
__device__ __forceinline__ void k_to_lds(ALAS unsigned char* lds, const u32x4 (&kk)[6], int tid) {
#pragma unroll
    for (int i = 0; i < 6; ++i) { const int chunk = tid + 512 * i, kvr = chunk >> 3, c = chunk & 7;
        *(ALAS u32x4*)(lds + LDS_K + kvr * 128 + ((c ^ ((kvr >> 1) & 7)) * 16)) = kk[i]; }
}
__device__ __forceinline__ void v_to_lds(ALAS unsigned char* lds, const u32x4 (&vv)[6], int tid) {
#pragma unroll
    for (int i = 0; i < 6; ++i) { const int chunk = tid + 512 * i, kvr = chunk >> 3, c = chunk & 7;
        *(ALAS u32x4*)(lds + LDS_V + (c >> 2) * 24576 + (kvr >> 3) * 512 + (kvr & 7) * 64 + (c & 3) * 16) = vv[i]; }
}

struct QState { f32x16 o0, o1; float mref, lrun; };
__device__ __forceinline__ void softmax_tile(f32x16& p, QState& Q, int ktp, int ql, int hi) {
    if (ktp == 0) {
#pragma unroll
        for (int r = 0; r < 16; ++r) { if ((r & 3) + 8 * (r >> 2) + 4 * hi < ql) p[r] = -INFINITY; }
    }
    if (ktp == 8) {
#pragma unroll
        for (int r = 0; r < 16; ++r) { if ((r & 3) + 8 * (r >> 2) + 4 * hi > ql) p[r] = -INFINITY; }
    }
    float tmax = max3f(max3f(p[0], p[1], p[2]), max3f(p[3], p[4], p[5]), max3f(p[6], p[7], p[8]));
    tmax = max3f(tmax, max3f(p[9], p[10], p[11]), max3f(p[12], p[13], p[14])); tmax = __builtin_fmaxf(tmax, p[15]);
    tmax = xl32_max(tmax);
    if (__builtin_expect(__any(tmax > THR), 0)) {
        const float dl = tmax > THR ? tmax : 0.f;
        Q.mref += dl;
        const float f = __builtin_amdgcn_exp2f(-dl);
        Q.lrun *= f;
#pragma unroll
        for (int r = 0; r < 16; ++r) { p[r] -= dl; Q.o0[r] *= f; Q.o1[r] *= f; }
    }
    float psum = 0.f;
#pragma unroll
    for (int r = 0; r < 16; ++r) { p[r] = __builtin_amdgcn_exp2f(p[r]); psum += p[r]; }
    Q.lrun += psum;
}
__device__ __forceinline__ bf16x8 pack_p(const f32x16& p, int s) {
    u32x4 pw; pw.x = cvtpk(p[8 * s + 0], p[8 * s + 1]); pw.y = cvtpk(p[8 * s + 2], p[8 * s + 3]); pw.z = cvtpk(p[8 * s + 4], p[8 * s + 5]); pw.w = cvtpk(p[8 * s + 6], p[8 * s + 7]);
    return __builtin_bit_cast(bf16x8, pw);
}
__device__ __forceinline__ f32x16 qk_tile(const bf16x8 (&q)[4], const QState& Q, const ALAS unsigned char* kbase, const ALAS float* bt, int kt, int ktp, int ql, int hi) {
    const int kvr = kt * 32 + ql;
    const ALAS unsigned char* krow = kbase + kvr * 128;
    const int ksw = (kvr >> 1) & 7;
    bf16x8 kf[4];
#pragma unroll
    for (int ds = 0; ds < 4; ++ds) kf[ds] = *(const ALAS bf16x8*)(krow + (((2 * ds + hi) ^ ksw) * 16));
    f32x16 p; const ALAS float* bp = bt + (32 + 32 * ktp - ql + 4 * hi);
#pragma unroll
    for (int r = 0; r < 16; ++r) p[r] = bp[(r & 3) + 8 * (r >> 2)];
    if (__builtin_expect(__any(Q.mref != 0.f), 0)) {
#pragma unroll
        for (int r = 0; r < 16; ++r) p[r] -= Q.mref; }
#pragma unroll
    for (int ds = 0; ds < 4; ++ds) p = __builtin_amdgcn_mfma_f32_32x32x16_bf16(kf[ds], q[ds], p, 0, 0, 0);
    return p;
}
__device__ __forceinline__ void softmax_pipe(f32x16& p, f32x16& pn, bool has_next, QState& Q, int ktp, int ql, int hi) {
    if (ktp == 0) {
#pragma unroll
        for (int r = 0; r < 16; ++r) { if ((r & 3) + 8 * (r >> 2) + 4 * hi < ql) p[r] = -INFINITY; }
    }
    if (ktp == 8) {
#pragma unroll
        for (int r = 0; r < 16; ++r) { if ((r & 3) + 8 * (r >> 2) + 4 * hi > ql) p[r] = -INFINITY; }
    }
    float tmax = max3f(max3f(p[0], p[1], p[2]), max3f(p[3], p[4], p[5]), max3f(p[6], p[7], p[8]));
    tmax = max3f(tmax, max3f(p[9], p[10], p[11]), max3f(p[12], p[13], p[14])); tmax = __builtin_fmaxf(tmax, p[15]);
    tmax = xl32_max(tmax);
    if (__builtin_expect(__any(tmax > THR), 0)) {
        const float dl = tmax > THR ? tmax : 0.f;
        Q.mref += dl;
        const float f = __builtin_amdgcn_exp2f(-dl);
        Q.lrun *= f;
#pragma unroll
        for (int r = 0; r < 16; ++r) { p[r] -= dl; Q.o0[r] *= f; Q.o1[r] *= f; }
        if (has_next) {
#pragma unroll
            for (int r = 0; r < 16; ++r) pn[r] -= dl; }
    }
    float psum = 0.f;
#pragma unroll
    for (int r = 0; r < 16; ++r) { p[r] = __builtin_amdgcn_exp2f(p[r]); psum += p[r]; }
    Q.lrun += psum;
}
__device__ __forceinline__ void pv_tile(QState& Q, const f32x16& p, const s16x4 (&vr)[2][4]) {
#pragma unroll
    for (int s = 0; s < 2; ++s) {
        const bf16x8 vf0 = (bf16x8){vr[s][0][0], vr[s][0][1], vr[s][0][2], vr[s][0][3], vr[s][1][0], vr[s][1][1], vr[s][1][2], vr[s][1][3]};
        const bf16x8 vf1 = (bf16x8){vr[s][2][0], vr[s][2][1], vr[s][2][2], vr[s][2][3], vr[s][3][0], vr[s][3][1], vr[s][3][2], vr[s][3][3]};
        const bf16x8 pf = pack_p(p, s);
        Q.o0 = __builtin_amdgcn_mfma_f32_32x32x16_bf16(vf0, pf, Q.o0, 0, 0, 0); Q.o1 = __builtin_amdgcn_mfma_f32_32x32x16_bf16(vf1, pf, Q.o1, 0, 0, 0);
    }
}
__device__ __forceinline__ void v_frags(s16x4 (&vr)[2][4], ALAS unsigned char* lds, int kt, int vlane) {
#pragma unroll
    for (int s = 0; s < 2; ++s) {
        const ALAS unsigned char* vp = lds + LDS_V + (4 * kt + 2 * s) * 512 + vlane;
        vr[s][0] = __builtin_bit_cast(s16x4, __builtin_amdgcn_ds_read_tr16_b64_v4i16((ALAS v4i16_t*)(vp)));
        vr[s][1] = __builtin_bit_cast(s16x4, __builtin_amdgcn_ds_read_tr16_b64_v4i16((ALAS v4i16_t*)(vp + 512)));
        vr[s][2] = __builtin_bit_cast(s16x4, __builtin_amdgcn_ds_read_tr16_b64_v4i16((ALAS v4i16_t*)(vp + 24576)));
        vr[s][3] = __builtin_bit_cast(s16x4, __builtin_amdgcn_ds_read_tr16_b64_v4i16((ALAS v4i16_t*)(vp + 24576 + 512)));
    }
}
__device__ __forceinline__ void run_qtile(QState& Q, const bf16x8 (&q)[4], const ALAS unsigned char* kbase, const ALAS float* bt, ALAS unsigned char* lds, int ot, int k0, int k1, int ql, int hi, int vlane) {
    f32x16 pa = qk_tile(q, Q, kbase, bt, k0, k0 - ot, ql, hi), pb = pa;
    int kt = k0;
    for (;;) {
        { s16x4 vr[2][4]; v_frags(vr, lds, kt, vlane);
          const bool nx = kt < k1;
          if (nx) pb = qk_tile(q, Q, kbase, bt, kt + 1, kt + 1 - ot, ql, hi);
          __builtin_amdgcn_sched_barrier(0);
          softmax_pipe(pa, pb, nx, Q, kt - ot, ql, hi);
          pv_tile(Q, pa, vr);
          if (!nx) break; ++kt; }
        { s16x4 vr[2][4]; v_frags(vr, lds, kt, vlane);
          const bool nx = kt < k1;
          if (nx) pa = qk_tile(q, Q, kbase, bt, kt + 1, kt + 1 - ot, ql, hi);
          __builtin_amdgcn_sched_barrier(0);
          softmax_pipe(pb, pa, nx, Q, kt - ot, ql, hi);
          pv_tile(Q, pb, vr);
          if (!nx) break; ++kt; }
    }
}
__device__ __forceinline__ void store_o(const QState& Q, bf16_t* __restrict__ O, int row, int h, int hi) {
    const float ltot = xl32_add(Q.lrun);
    const float inv = 1.0f / ltot;
    bf16_t* orow = O + (size_t)row * O_LD + h * 64 + 4 * hi;
#pragma unroll
    for (int rg = 0; rg < 4; ++rg) {
        u32x2 w0, w1;
        w0.x = cvtpk(Q.o0[4 * rg] * inv, Q.o0[4 * rg + 1] * inv); w0.y = cvtpk(Q.o0[4 * rg + 2] * inv, Q.o0[4 * rg + 3] * inv);
        w1.x = cvtpk(Q.o1[4 * rg] * inv, Q.o1[4 * rg + 1] * inv); w1.y = cvtpk(Q.o1[4 * rg + 2] * inv, Q.o1[4 * rg + 3] * inv);
        *(u32x2*)(orow + 8 * rg) = w0; *(u32x2*)(orow + 32 + 8 * rg) = w1;
    }
}

__device__ __forceinline__ void attn_phase(ALAS unsigned char* lds, const bf16_t* __restrict__ QKV, bf16_t* __restrict__ O, const float* __restrict__ biasg, const float* __restrict__ sink2,
                                           int first, int stride, int nunits) {
    int tid_ = threadIdx.x; asm volatile("" : "+v"(tid_));
    const int tid = tid_, lane = tid & 63, ql = lane & 31, hi = lane >> 5;
    const int wid = __builtin_amdgcn_readfirstlane(tid >> 6);
    const int r4 = wid >> 1, qh = wid & 1;
    for (int i = tid; i < 16 * BT_STRIDE; i += 512) ((ALAS float*)(lds + LDS_BT))[i] = biasg[i] - sink2[i / BT_STRIDE];
    const ALAS unsigned char* kbase = lds + LDS_K;
    const int vlane = (4 * hi + ((lane & 15) >> 2)) * 64 + ((lane >> 4) & 1) * 32 + (lane & 3) * 8;
    u32x4 pk[6], pv[6];
    if (first < nunits) { const UnitPos P0 = unit_pos(slot_unit(first, stride, nunits)); band_fetch(pk, QKV, P0, tid, KOFF); band_fetch(pv, QKV, P0, tid, VOFF); }
    for (int u = first; u < nunits; u += stride) {
        const UnitPos P = unit_pos(slot_unit(u, stride, nunits));
        const int h = P.g * 4 + r4;
        const int R0 = P.rowbase + P.q0 + qh * 64;
        bf16x8 qr[2][4];
#pragma unroll
        for (int qt = 0; qt < 2; ++qt)
#pragma unroll
            for (int ds = 0; ds < 4; ++ds) qr[qt][ds] = *(const bf16x8*)(QKV + (size_t)(R0 + qt * 32 + ql) * QKV_LD + h * 64 + ds * 16 + hi * 8);
        __syncthreads();
        k_to_lds(lds, pk, tid); v_to_lds(lds, pv, tid);
        __syncthreads();
        if (u + stride < nunits) { const UnitPos Pn = unit_pos(slot_unit(u + stride, stride, nunits)); band_fetch(pk, QKV, Pn, tid, KOFF); band_fetch(pv, QKV, Pn, tid, VOFF); }
        const ALAS float* bt = (const ALAS float*)(lds + LDS_BT) + h * BT_STRIDE;
        const int ktlo = (P.q0 == 0) ? 4 : 0, kthi = (P.q0 + 128 >= P.S) ? 7 : 11;
#pragma unroll
        for (int qt = 0; qt < 2; ++qt) {
            const int ot = qh * 2 + qt;
            int k0 = ot, k1 = ot + 8; if (k0 < ktlo) k0 = ktlo; if (k1 > kthi) k1 = kthi;
            QState Q; Q.mref = 0.f; Q.lrun = (hi == 0) ? 1.0f : 0.0f;
#pragma unroll
            for (int r = 0; r < 16; ++r) { Q.o0[r] = 0.f; Q.o1[r] = 0.f; }
            run_qtile(Q, qr[qt], kbase, bt, lds, ot, k0, k1, ql, hi, vlane);
            store_o(Q, O, R0 + qt * 32 + ql, h, hi);
        }
    }
    __syncthreads();
}
}
constexpr int NWAVES = 8;
constexpr int D = 1024, FF = 4096, PLE = 256, DEPTH = 4;
constexpr int MP = 65536, MS = 16384, M = MP + MS;
constexpr int SEQ_P = 4096, SEQ_S = 2048;
constexpr int NQKV = 1536, NCIN = 3072;
constexpr size_t MiB = 1u << 20;
constexpr size_t WS_BIAS = 0;
constexpr size_t WS_SINK = 32 * 1024;
constexpr size_t WS_BAR = 64 * 1024, WS_BAR_BYTES = 16 * 1024;
constexpr int MISC_OFF = 131072 + 320;
constexpr size_t WS_SS = 948 * MiB;
constexpr size_t WS_W = 8 * MiB;
constexpr size_t WS_XB = 108 * MiB;
constexpr size_t WS_PB = 268 * MiB;
constexpr size_t WS_H = 308 * MiB;
constexpr size_t SLOT = 160 * MiB;
constexpr size_t WS_END = WS_H + 4 * SLOT + 12 * MiB;
constexpr size_t W_QKV = 0;
constexpr size_t W_O = W_QKV + 2ull * NQKV * D;
constexpr size_t W_CIN = W_O + 2ull * D * D;
constexpr size_t W_COUT = W_CIN + 2ull * NCIN * D;
constexpr size_t W_UP = W_COUT + 2ull * D * D;
constexpr size_t W_DN = W_UP + 4ull * FF * D;
constexpr size_t W_G = W_DN + 4ull * FF * D;
constexpr size_t W_P = W_G + 4ull * D * D;
constexpr size_t W_TOTAL = W_P + 4ull * D * PLE;
static_assert(W_TOTAL * 2 <= 100 * MiB, "weight region");
constexpr int N_PHASES_C = 1 + 6 * 4 + 1;
constexpr int LDS_BYTES = 147456;
static_assert(pg8::STAGE_BYTES <= 131072 && attn::LDS_BYTES <= 131072, "LDS map");

#define LAS __attribute__((address_space(3)))
typedef unsigned short bf16;
typedef unsigned v4u __attribute__((ext_vector_type(4)));
typedef unsigned v2u __attribute__((ext_vector_type(2)));
typedef float f32x4 __attribute__((ext_vector_type(4)));
__device__ __forceinline__ unsigned f2bf(float f) { unsigned u = __builtin_bit_cast(unsigned, f); return (u + 0x7fffu + ((u >> 16) & 1u)) >> 16; }
__device__ __forceinline__ unsigned pk2(float lo, float hi) { return f2bf(lo) | (f2bf(hi) << 16); }
__device__ __forceinline__ float wave_sum(float v) {
#pragma unroll
    for (int o = 1; o < 64; o <<= 1) v += __shfl_xor(v, o);
    return v;
}

#define XB_TMO      128
#define XB_XCNT(j)  (256  + 64 * (j))
#define XB_XSUB(j)  (1280 + 64 * (j))
#define XB_XGEN(j)  (2304 + 64 * (j))
#define XB_TOP      3328
#define XB_TOPGEN   3392
#define XCD_BAR_WORDS 3456
#define XB_SPIN_CAP (1u << 18)

__device__ __forceinline__ unsigned xb_ld(unsigned* p)              { return __hip_atomic_load(p, __ATOMIC_RELAXED, __HIP_MEMORY_SCOPE_AGENT); }
__device__ __forceinline__ unsigned xb_add(unsigned* p, unsigned v) { return __hip_atomic_fetch_add(p, v, __ATOMIC_RELAXED, __HIP_MEMORY_SCOPE_AGENT); }
__device__ __forceinline__ unsigned xb_xcc_id() { return (unsigned)__builtin_amdgcn_s_getreg((3 << 11) | 20) & 0xFu; }
#define XB_SPIN(cond, bar) do { unsigned _sp = 0; while (cond) { __builtin_amdgcn_s_sleep(1); \
    if ((++_sp & 255u) == 0u) { if (xb_ld(&(bar)[XB_TMO])) break; if (_sp > XB_SPIN_CAP) { atomicAdd(&(bar)[XB_TMO], 1u); break; } } } } while (0)

struct XcdBarrier {
    unsigned* bar; unsigned x;
    volatile LAS unsigned* st;
};

__device__ __forceinline__ XcdBarrier xcd_barrier_post(unsigned* bar, volatile LAS unsigned* st) {
    XcdBarrier b; b.bar = bar; b.x = xb_xcc_id(); b.st = st;
    if (threadIdx.x == 0) (void)xb_add(&bar[XB_XCNT(b.x)], 1u);
    return b;
}
__device__ __forceinline__ void xcd_barrier_complete(unsigned* bar, unsigned x, unsigned& nloc, unsigned& nx) {
    const unsigned G = gridDim.x * gridDim.y * gridDim.z;
    unsigned sum, cnt, mine, sp = 0u;
    for (;;) {
        sum = 0u; cnt = 0u; mine = 0u;
#pragma unroll
        for (unsigned j = 0; j < 16; ++j) { const unsigned c = xb_ld(&bar[XB_XCNT(j)]); sum += c; cnt += (c > 0u) ? 1u : 0u; mine = (j == x) ? c : mine; }
        if (sum == G) break;
        __builtin_amdgcn_s_sleep(1);
        if ((++sp & 255u) == 0u) { if (xb_ld(&bar[XB_TMO])) break; if (sp > XB_SPIN_CAP) { atomicAdd(&bar[XB_TMO], 1u); break; } }
    }
    nloc = mine > 0u ? mine : 1u; nx = cnt > 0u ? cnt : 1u;
}

__device__ __forceinline__ void xcd_barrier(const XcdBarrier& b) {
    asm volatile("s_waitcnt vmcnt(0)" ::: "memory");
    __syncthreads();
    if (threadIdx.x == 0) {
        unsigned* bar = b.bar;
        __builtin_amdgcn_s_waitcnt(0);
        unsigned nloc = b.st[0], nx = b.st[1];
        if (nloc == 0u) { xcd_barrier_complete(bar, b.x, nloc, nx); b.st[0] = nloc; b.st[1] = nx; }
        const unsigned old = xb_add(&bar[XB_XSUB(b.x)], 1u);
        const unsigned gen = old / nloc;
        if (old + 1u == (gen + 1u) * nloc) {
            __builtin_amdgcn_fence(__ATOMIC_RELEASE, "agent");
            asm volatile("s_waitcnt vmcnt(0)" ::: "memory");
            const unsigned og = xb_add(&bar[XB_TOP], 1u);
            const unsigned tg = og / nx;
            if (og + 1u == (tg + 1u) * nx) xb_add(&bar[XB_TOPGEN], 1u);
            else XB_SPIN(xb_ld(&bar[XB_TOPGEN]) == tg, bar);
            __builtin_amdgcn_fence(__ATOMIC_ACQUIRE, "agent");
            xb_add(&bar[XB_XGEN(b.x)], 1u);
            asm volatile("s_waitcnt vmcnt(0)" ::: "memory");
        } else {
            XB_SPIN(xb_ld(&bar[XB_XGEN(b.x)]) == gen, bar);
            __builtin_amdgcn_fence(__ATOMIC_ACQUIRE, "agent");
            asm volatile("s_waitcnt vmcnt(0)" ::: "memory");
        }
    }
    __syncthreads();
}

struct Args {
    const float* in[19];
    float* out; unsigned char* ws;
    int ph_lo, ph_hi;
};

__device__ __forceinline__ int cin_row(int n) { if (n < 1024) return n; if (n < 2048) { const int c = n - 1024; return 1024 + (c >> 7) * 256 + (c & 127); } const int c = n - 2048; return 1024 + (c >> 7) * 256 + 128 + (c & 127); }
__device__ __forceinline__ void transpose_item(const float* __restrict__ W, int K, int N, bf16* __restrict__ WT, const float* __restrict__ gk, int mode, LAS float* scr, int item, int lane) {
    const int nblk = N / 32, kb = item / nblk, nb = item % nblk, k0 = 64 * kb, n0 = 32 * nb;
    float wv[32];
#pragma unroll
    for (int i = 0; i < 32; ++i) wv[i] = W[(size_t)(k0 + 2 * i + (lane >> 5)) * N + n0 + (lane & 31)];
#pragma unroll
    for (int i = 0; i < 32; ++i) { const int kk = 2 * i + (lane >> 5); float v = wv[i]; if (gk) v *= gk[k0 + kk]; scr[kk * 33 + (lane & 31)] = v; }
    asm volatile("s_waitcnt lgkmcnt(0)" ::: "memory");
    const int c = lane & 7;
    const int r0 = mode ? cin_row(n0) : n0;
#pragma unroll
    for (int j = 0; j < 4; ++j) { const int n = (lane >> 3) + 8 * j; const LAS float* s = scr + (8 * c) * 33 + n;
        v4u o; o.x = pk2(s[0 * 33], s[1 * 33]); o.y = pk2(s[2 * 33], s[3 * 33]); o.z = pk2(s[4 * 33], s[5 * 33]); o.w = pk2(s[6 * 33], s[7 * 33]);
        *(v4u*)(WT + (size_t)(r0 + n) * K + k0 + 8 * c) = o; }
    asm volatile("s_waitcnt lgkmcnt(0)" ::: "memory");
}

__device__ __forceinline__ int row_of(int v, bool descending) { const int vg = v / 16384, rem = v - vg * 16384, g = descending ? 4 - vg : vg; return ((rem >> 11) * 40 + g * 8) * 256 + (rem & 2047); }
__device__ __forceinline__ int t5_bucket(int rel) {
    const int n = rel < 0 ? -rel : rel; int b;
    if (n < 8) b = n; else { b = 8 + (n >= 12) + (n >= 16) + (n >= 23) + (n >= 32) + (n >= 46) + (n >= 64) + (n >= 91); if (b > 15) b = 15; }
    return (rel > 0 ? 16 : 0) + b;
}

__global__ void __launch_bounds__(NWAVES * 64, 2) fwd_kernel(Args a) {
    extern __shared__ __attribute__((aligned(16))) unsigned char lds_raw[];
    LAS unsigned char* lds = (LAS unsigned char*)lds_raw;
    cg::grid_group grid = cg::this_grid();
    const int G = gridDim.x, bx = blockIdx.x;
    if (threadIdx.x < 32) ((volatile LAS unsigned*)(lds + MISC_OFF))[threadIdx.x] = 0u;
    __syncthreads();
    const XcdBarrier xbar = xcd_barrier_post((unsigned*)(a.ws + WS_BAR), (volatile LAS unsigned*)(lds + MISC_OFF) + 8);
    const int NGW = G * NWAVES, NGT = G * NWAVES * 64;
#define TID_LOCALS() int tid_ = threadIdx.x; asm volatile("" : "+v"(tid_)); const int tid = tid_, lane = tid & 63, wave = __builtin_amdgcn_readfirstlane(tid >> 6), gw = bx * NWAVES + wave, gt = bx * (NWAVES * 64) + tid; (void)lane; (void)gw; (void)gt;
    unsigned char* ws = a.ws;
    const float* x_prompt = a.in[0]; const float* x_sample = a.in[1]; const float* p_prompt = a.in[2]; const float* p_sample = a.in[3];
    const float* rel_bias = a.in[4]; const float* attn_w_qkv = a.in[5]; const float* attn_w_o = a.in[6]; const float* attn_sink = a.in[7];
    const float* conv_w_in = a.in[8]; const float* conv_w = a.in[9]; const float* conv_w_out = a.in[10]; const float* mlp_w_up = a.in[11];
    const float* mlp_w_down = a.in[12]; const float* ple_w_gate = a.in[13]; const float* ple_w_proj = a.in[14];
    const float* norm_mix = a.in[15]; const float* norm_mlp = a.in[16]; const float* norm_ple = a.in[17]; const float* final_norm = a.in[18];
    float* out = a.out;
    float* biasg = (float*)(ws + WS_BIAS); float* sink2 = (float*)(ws + WS_SINK); float* SS = (float*)(ws + WS_SS);
    bf16* Wb = (bf16*)(ws + WS_W); bf16* XBm = (bf16*)(ws + WS_XB); bf16* PB = (bf16*)(ws + WS_PB);
    bf16* S0 = (bf16*)(ws + WS_H); bf16* S2 = (bf16*)(ws + WS_H + 2 * SLOT); bf16* S3 = (bf16*)(ws + WS_H + 3 * SLOT);
    const int lo = a.ph_lo, hi = a.ph_hi;
    int ph = 0;
#define IN_PH() (lo <= ph && ph < hi)
#ifndef SEAM_REPS
#define SEAM_REPS 1
#endif
#ifndef ATTN_REPS
#define ATTN_REPS 1
#endif
#ifndef UP_REPS
#define UP_REPS 1
#endif
#define SEAM() do { if (lo <= ph && ph + 1 < hi) { T_BEGIN(); _Pragma("unroll 1") for (int rep_ = 0; rep_ < SEAM_REPS; ++rep_) { if (ph == 0) { asm volatile("s_waitcnt vmcnt(0) lgkmcnt(0)" ::: "memory"); grid.sync(); __builtin_amdgcn_fence(__ATOMIC_ACQUIRE, "agent"); asm volatile("s_waitcnt vmcnt(0)" ::: "memory"); } else { xcd_barrier(xbar); } } T_END(3); } ++ph; } while (0)

#if defined(PROBE_A)
    unsigned long long tA = 0, tB = 0, tS = 0;
#define T_BEGIN() do { tS = __builtin_amdgcn_s_memrealtime(); } while (0)
#define T_END(cat) do { const unsigned long long d_ = __builtin_amdgcn_s_memrealtime() - tS; if ((cat) == PROBE_A) tA += d_; if ((cat) == PROBE_B) tB += d_; } while (0)
#else
#define T_BEGIN() do { } while (0)
#define T_END(cat) do { } while (0)
#endif
    if (IN_PH()) {
        T_BEGIN();
        TID_LOCALS();
        LAS float* scr = (LAS float*)(lds + wave * 16384);
#ifndef PRO_REPS
#define PRO_REPS 1
#endif
#pragma unroll 1
        for (int rep = 0; rep < PRO_REPS; ++rep) {
        constexpr int I_QKV = 16 * 48, I_CIN = 16 * 96, I_SQ = 16 * 32, I_UP = 16 * 128, I_DN = 64 * 32, I_P = 4 * 32;
        constexpr int L_EVEN = I_QKV + I_SQ + I_UP + I_DN + I_SQ + I_P, L_ODD = I_CIN + I_SQ + I_UP + I_DN + I_SQ + I_P;
        constexpr int NITEMS = 2 * (L_EVEN + L_ODD);
        for (int k_ = 0; ; ++k_) {
            const int it = gw + k_ * NGW, v0 = gw + k_ * 2 * NGW;
            if (it >= NITEMS && v0 >= M) break;
            if (it < NITEMS) do {
            int r = it; const int pair = r / (L_EVEN + L_ODD); r -= pair * (L_EVEN + L_ODD);
            int i = 2 * pair; if (r >= L_EVEN) { r -= L_EVEN; i += 1; }
            const int j = pair; const bool odd = i & 1;
            const int I_IN = odd ? I_CIN : I_QKV;
            if (r < I_IN) {
                if (odd) transpose_item(conv_w_in + (size_t)j * D * NCIN, D, NCIN, Wb + W_CIN + (size_t)j * NCIN * D, norm_mix + i * D, 1, scr, r, lane);
                else transpose_item(attn_w_qkv + (size_t)j * D * NQKV, D, NQKV, Wb + W_QKV + (size_t)j * NQKV * D, norm_mix + i * D, 0, scr, r, lane);
                break; }
            r -= I_IN;
            if (r < I_SQ) {
                if (odd) transpose_item(conv_w_out + (size_t)j * D * D, D, D, Wb + W_COUT + (size_t)j * D * D, nullptr, 0, scr, r, lane);
                else transpose_item(attn_w_o + (size_t)j * D * D, D, D, Wb + W_O + (size_t)j * D * D, nullptr, 0, scr, r, lane);
                break; }
            r -= I_SQ;
            if (r < I_UP) { transpose_item(mlp_w_up + (size_t)i * D * FF, D, FF, Wb + W_UP + (size_t)i * FF * D, norm_mlp + i * D, 0, scr, r, lane); break; }
            r -= I_UP;
            if (r < I_DN) { transpose_item(mlp_w_down + (size_t)i * FF * D, FF, D, Wb + W_DN + (size_t)i * D * FF, nullptr, 0, scr, r, lane); break; }
            r -= I_DN;
            if (r < I_SQ) { transpose_item(ple_w_gate + (size_t)i * D * D, D, D, Wb + W_G + (size_t)i * D * D, norm_ple + i * D, 0, scr, r, lane); break; }
            r -= I_SQ;
            transpose_item(ple_w_proj + (size_t)i * PLE * D, PLE, D, Wb + W_P + (size_t)i * D * PLE, nullptr, 0, scr, r, lane);

            } while (0);
            if (v0 < M) {
            const int m = row_of(v0, true), m2 = row_of((v0 + NGW < M) ? v0 + NGW : v0, true);
            const float* xr = (m < MP) ? x_prompt + (size_t)m * D : x_sample + (size_t)(m - MP) * D;
            const float* xr2 = (m2 < MP) ? x_prompt + (size_t)m2 * D : x_sample + (size_t)(m2 - MP) * D;
            const f32x4* x4 = (const f32x4*)xr + lane; const f32x4* y4 = (const f32x4*)xr2 + lane; float s = 0.f, s2 = 0.f; f32x4 v[4], w4[4];
#pragma unroll
            for (int j = 0; j < 4; ++j) { v[j] = x4[64 * j]; w4[j] = y4[64 * j]; }
#pragma unroll
            for (int j = 0; j < 4; ++j) { s += (v[j].x * v[j].x + v[j].y * v[j].y) + (v[j].z * v[j].z + v[j].w * v[j].w); s2 += (w4[j].x * w4[j].x + w4[j].y * w4[j].y) + (w4[j].z * w4[j].z + w4[j].w * w4[j].w); }
            s = wave_sum(s); s2 = wave_sum(s2);
            v2u* o8 = (v2u*)(S3 + (size_t)m * D) + lane; v2u* p8 = (v2u*)(S3 + (size_t)m2 * D) + lane;
#pragma unroll
            for (int j = 0; j < 4; ++j) { v2u w; w.x = pk2(v[j].x, v[j].y); w.y = pk2(v[j].z, v[j].w); o8[64 * j] = w; v2u z; z.x = pk2(w4[j].x, w4[j].y); z.y = pk2(w4[j].z, w4[j].w); p8[64 * j] = z; }
            if (lane < 16) { SS[(size_t)m * 16 + lane] = (lane == 0) ? s : 0.f; SS[(size_t)m2 * 16 + lane] = (lane == 0) ? s2 : 0.f; }

            }
        }
        for (int i = gt; i < 16 * 320; i += NGT) {
            const int h = i / 320, e = i % 320, t = e - 32; float v = 0.f;
            if (t >= 0 && t <= 256) v = rel_bias[t5_bucket(t - 128) * 16 + h] * 1.4426950408889634f;
            biasg[i] = v;
        }
        if (gt < 32) sink2[gt] = attn_sink[gt] * 1.4426950408889634f;
        }
        T_END(4);
    }
    SEAM();

#pragma unroll 1
    for (int i = 0; i < DEPTH; ++i) {
        const int j = i >> 1; const bool odd = i & 1;
        if (IN_PH()) {
            T_BEGIN();
            TID_LOCALS();
            if (!odd) {
                pg8::Gemm g{S3, Wb + W_QKV + (size_t)j * NQKV * D, M, NQKV, D}; pg8::StaticOrder S; S.init(M, NQKV, G, bx);
                pg8::EpiBf16R<1> E{S0, NQKV, SS + (size_t)((3 * i) & 1) * M * 16};
#ifndef NO_QKV
                pg8::gemm_phase<pg8::EpiBf16R<1>, pg8::StaticOrder, true, true>(lds, g, S, E);
#endif
            } else {
                pg8::Gemm g{S3, Wb + W_CIN + (size_t)j * NCIN * D, M, NCIN, D}; pg8::StaticOrder S; S.init(M, NCIN, G, bx);
                pg8::EpiBf16R<3> E{S0, 2048, SS + (size_t)((3 * i) & 1) * M * 16};
#ifndef NO_CIN
                pg8::gemm_phase<pg8::EpiBf16R<3>, pg8::StaticOrder, true, true>(lds, g, S, E);
#endif
            }
            T_END(1);
        }
        SEAM();
        if (IN_PH()) {
            T_BEGIN();
            TID_LOCALS();
            if (!odd) {
#pragma unroll 1
                for (int rep = 0; rep < ATTN_REPS; ++rep)
#ifndef NO_ATTN
                attn::attn_phase(lds, S0, S2, biasg, sink2 + j * 16, bx, G, 640 * 4);
#endif
            } else {
                const float* cw = conv_w + (size_t)j * 3 * D;
                const int c8 = (gt & 127) * 8;
                const f32x4 w0a = *(const f32x4*)(cw + c8), w0b = *(const f32x4*)(cw + c8 + 4), w1a = *(const f32x4*)(cw + D + c8), w1b = *(const f32x4*)(cw + D + c8 + 4),
                            w2a = *(const f32x4*)(cw + 2 * D + c8), w2b = *(const f32x4*)(cw + 2 * D + c8 + 4);
                constexpr int NCC = M * (D / 8);
                for (int c = gt; c < NCC; c += 2 * NGT) {
                    v4u bbv[2], zcv[2], zmv[2], zpv[2]; int rowv[2];
#pragma unroll
                    for (int q = 0; q < 2; ++q) {
                        const int cq = (c + q * NGT < NCC) ? c + q * NGT : c;
                        const int v = cq >> 7, gq = 4 - v / 16384, rem = v % 16384;
                        const int row = ((rem >> 11) * 40 + gq * 8) * 256 + (rem & 2047); rowv[q] = row;
                        const int pos = (row < MP) ? (row & (SEQ_P - 1)) : ((row - MP) & (SEQ_S - 1));
                        const int Sq = (row < MP) ? SEQ_P : SEQ_S;
                        const bf16* bz = S0 + (size_t)row * 2048;
                        bbv[q] = *(const v4u*)(bz + c8); zcv[q] = *(const v4u*)(bz + 1024 + c8);
                        zmv[q] = (v4u){0u, 0u, 0u, 0u}; zpv[q] = (v4u){0u, 0u, 0u, 0u};
                        if (pos > 0) zmv[q] = *(const v4u*)(bz - 2048 + 1024 + c8);
                        if (pos < Sq - 1) zpv[q] = *(const v4u*)(bz + 2048 + 1024 + c8);
                    }
#pragma unroll
                    for (int q = 0; q < 2; ++q) {
                        const v4u bb = bbv[q], zc = zcv[q], zm = zmv[q], zp = zpv[q];
                        float r[8];
#define CV(e, W0, W1, W2, ZM, ZC, ZP, BB, LOHI) r[e] = LOHI(BB) * (W0 * LOHI(ZM) + W1 * LOHI(ZC) + W2 * LOHI(ZP))
                        CV(0, w0a.x, w1a.x, w2a.x, zm.x, zc.x, zp.x, bb.x, pg8::bf_lo); CV(1, w0a.y, w1a.y, w2a.y, zm.x, zc.x, zp.x, bb.x, pg8::bf_hi);
                        CV(2, w0a.z, w1a.z, w2a.z, zm.y, zc.y, zp.y, bb.y, pg8::bf_lo); CV(3, w0a.w, w1a.w, w2a.w, zm.y, zc.y, zp.y, bb.y, pg8::bf_hi);
                        CV(4, w0b.x, w1b.x, w2b.x, zm.z, zc.z, zp.z, bb.z, pg8::bf_lo); CV(5, w0b.y, w1b.y, w2b.y, zm.z, zc.z, zp.z, bb.z, pg8::bf_hi);
                        CV(6, w0b.z, w1b.z, w2b.z, zm.w, zc.w, zp.w, bb.w, pg8::bf_lo); CV(7, w0b.w, w1b.w, w2b.w, zm.w, zc.w, zp.w, bb.w, pg8::bf_hi);
#undef CV
                        v4u w; w.x = pk2(r[0], r[1]); w.y = pk2(r[2], r[3]); w.z = pk2(r[4], r[5]); w.w = pk2(r[6], r[7]);
                        *(v4u*)(S2 + (size_t)rowv[q] * D + c8) = w;
                    }
                }
            }
            T_END((odd ? 5 : 2));
        }
        SEAM();
        if (IN_PH()) {
            T_BEGIN();
            pg8::Gemm g{S2, odd ? Wb + W_COUT + (size_t)j * D * D : Wb + W_O + (size_t)j * D * D, M, D, D}; pg8::StaticOrder S; S.init(M, D, G, bx);
            pg8::EpiResid<0> E{S3, XBm, SS + (size_t)((3 * i + 1) & 1) * M * 16, nullptr, nullptr};
#ifndef NO_MIXOUT
#ifndef MIX_REPS
#define MIX_REPS 1
#endif
#pragma unroll 1
            for (int rep = 0; rep < MIX_REPS; ++rep)
            pg8::gemm_phase<pg8::EpiResid<0>, pg8::StaticOrder, true, true>(lds, g, S, E);
#endif
            T_END(6);
        }
        SEAM();
        if (IN_PH()) {
            T_BEGIN();
            pg8::Gemm g{XBm, Wb + W_UP + (size_t)i * FF * D, M, FF, D}; pg8::StaticOrder S; S.init(M, FF, G, bx); S.reverse();
            pg8::EpiBf16R<2> E{S0, FF, SS + (size_t)((3 * i + 1) & 1) * M * 16};
#ifndef NO_UP
#pragma unroll 1
            for (int rep = 0; rep < UP_REPS; ++rep)
            pg8::gemm_phase<pg8::EpiBf16R<2>, pg8::StaticOrder, true, true>(lds, g, S, E);
#endif
            T_END(7);
        }
        SEAM();
        if (IN_PH()) {
            T_BEGIN();
            pg8::Gemm g{S0, Wb + W_DN + (size_t)i * D * FF, M, D, FF}; pg8::StaticOrder S; S.init(M, D, G, bx);
            pg8::EpiResid<2> E{XBm, XBm, SS + (size_t)((3 * i + 2) & 1) * M * 16, SS + (size_t)((3 * i + 1) & 1) * M * 16, nullptr};
#ifndef NO_DOWN
            pg8::gemm_phase<pg8::EpiResid<2>, pg8::StaticOrder, true, true>(lds, g, S, E);
#endif
            { TID_LOCALS();
            const float* pp = p_prompt + (size_t)i * MP * PLE; const float* ps = p_sample + (size_t)i * MS * PLE;
            constexpr int NCH = M * PLE / 8;
            for (int c = gt; c < NCH; c += 4 * NGT) {
                f32x4 a0[4], a1[4]; size_t eo[4];
#pragma unroll
                for (int q = 0; q < 4; ++q) {
                    const int cq = (c + q * NGT < NCH) ? c + q * NGT : c;
                    eo[q] = (size_t)cq * 8;
                    const float* src = (eo[q] < (size_t)MP * PLE) ? pp + eo[q] : ps + (eo[q] - (size_t)MP * PLE);
                    a0[q] = *(const f32x4*)src; a1[q] = *(const f32x4*)(src + 4);
                }
#pragma unroll
                for (int q = 0; q < 4; ++q) { v4u w; w.x = pk2(a0[q].x, a0[q].y); w.y = pk2(a0[q].z, a0[q].w); w.z = pk2(a1[q].x, a1[q].y); w.w = pk2(a1[q].z, a1[q].w); *(v4u*)(PB + eo[q]) = w; }
            }
            }
            T_END(8);
        }
        SEAM();
        if (IN_PH()) {
            T_BEGIN();
#ifndef PLE_REPS
#define PLE_REPS 1
#endif
#pragma unroll 1
            for (int rep = 0; rep < PLE_REPS; ++rep) {
            {
                pg8::Gemm g{PB, Wb + W_P + (size_t)i * D * PLE, M, D, PLE}; pg8::StaticOrder S; S.init(M, D, G, bx); S.reverse();
                pg8::EpiBf16R<0> E{S0, D, nullptr};
#ifndef NO_PROJ
                pg8::gemm_phase<pg8::EpiBf16R<0>, pg8::StaticOrder, true, true>(lds, g, S, E);
#endif
            }
            {
                pg8::Gemm g{XBm, Wb + W_G + (size_t)i * D * D, M, D, D}; pg8::StaticOrder S; S.init(M, D, G, bx); S.reverse();
                pg8::EpiResid<1> E{XBm, S3, SS + (size_t)((3 * i + 3) & 1) * M * 16, SS + (size_t)((3 * i + 2) & 1) * M * 16, S0};
#ifndef NO_GATE
                pg8::gemm_phase<pg8::EpiResid<1>, pg8::StaticOrder, true, true>(lds, g, S, E);
#endif
            }
            }
            T_END(9);
        }
        SEAM();
    }
    if (IN_PH()) {
        T_BEGIN();
        TID_LOCALS();
        const float* ssf = SS;
        for (int v0 = gw; v0 < M; v0 += 2 * NGW) {
            const int mm[2] = {row_of(v0, false), row_of((v0 + NGW < M) ? v0 + NGW : v0, false)};
            v2u xw[2][4]; pg8::f32x4 sv[2][4];
#pragma unroll
            for (int r = 0; r < 2; ++r) { const v2u* xb = (const v2u*)(S3 + (size_t)mm[r] * D) + lane; const pg8::f32x4* sp = (const pg8::f32x4*)(ssf + (size_t)mm[r] * 16);
#pragma unroll
                for (int q = 0; q < 4; ++q) { xw[r][q] = xb[64 * q]; sv[r][q] = sp[q]; } }
#pragma unroll
            for (int r = 0; r < 2; ++r) {
                const pg8::f32x4 s0 = sv[r][0], s1 = sv[r][1], s2 = sv[r][2], s3 = sv[r][3];
                const float rs = __builtin_amdgcn_rsqf(((((s0[0] + s0[1]) + (s0[2] + s0[3])) + ((s1[0] + s1[1]) + (s1[2] + s1[3]))) + (((s2[0] + s2[1]) + (s2[2] + s2[3])) + ((s3[0] + s3[1]) + (s3[2] + s3[3])))) * (1.0f / 1024.0f) + 1e-6f);
                f32x4* o4 = (f32x4*)(out + (size_t)mm[r] * D) + lane; const f32x4* g4 = (const f32x4*)final_norm + lane;
#pragma unroll
                for (int q = 0; q < 4; ++q) { const v2u w = xw[r][q]; const f32x4 gg = g4[64 * q]; f32x4 v; v.x = pg8::bf_lo(w.x); v.y = pg8::bf_hi(w.x); v.z = pg8::bf_lo(w.y); v.w = pg8::bf_hi(w.y); o4[64 * q] = v * rs * gg; }
            }
        }
        T_END(5);
    }
#if defined(PROBE_A)
    asm volatile("s_waitcnt vmcnt(0)" ::: "memory");
    if (blockIdx.x == 0 && threadIdx.x == 0 && hi == N_PHASES_C) { out[0] = (float)tA; out[1] = (float)tB; }
#endif
#undef IN_PH
#undef SEAM
}

constexpr int N_PHASES = 1 + 6 * DEPTH + 1;
extern "C" void kernel_launch(void* const* d_in, const int* in_sizes, int n_in, void* d_out, int out_size, void* d_ws, size_t ws_size, hipStream_t stream) {
    static int grid = 0;
    if (grid == 0) {
        if (n_in != 19 || out_size != M * D || ws_size < WS_END) { fprintf(stderr, "kernel_launch: unexpected shapes (n_in %d out %d ws %zu need %zu)\n", n_in, out_size, ws_size, (size_t)WS_END); grid = -1; return; }
        int dev = 0, cus = 0, per_cu = 0;
        hipGetDevice(&dev); hipDeviceGetAttribute(&cus, hipDeviceAttributeMultiprocessorCount, dev);
        if (hipFuncSetAttribute((const void*)fwd_kernel, hipFuncAttributeMaxDynamicSharedMemorySize, LDS_BYTES) != hipSuccess) { fprintf(stderr, "hipFuncSetAttribute failed\n"); grid = -1; return; }
        if (hipOccupancyMaxActiveBlocksPerMultiprocessor(&per_cu, (const void*)fwd_kernel, NWAVES * 64, LDS_BYTES) != hipSuccess || per_cu < 1) { fprintf(stderr, "occupancy query failed (%d)\n", per_cu); per_cu = 1; (void)hipGetLastError(); }
        grid = cus * per_cu;
    }
    if (grid < 0) return;
    if (hipMemsetAsync((char*)d_ws + WS_BAR, 0, WS_BAR_BYTES, stream) != hipSuccess) { fprintf(stderr, "memset failed\n"); return; }
    Args a{};
    for (int i = 0; i < 19; ++i) a.in[i] = (const float*)d_in[i];
    a.out = (float*)d_out; a.ws = (unsigned char*)d_ws;
#if defined(MK_MULTI)
    for (int p = 0; p < N_PHASES; ++p) { a.ph_lo = p; a.ph_hi = p + 1; hipLaunchKernelGGL(fwd_kernel, dim3(grid), dim3(NWAVES * 64), LDS_BYTES, stream, a); }
#else
    a.ph_lo = 0; a.ph_hi = N_PHASES;
    void* args[] = {&a};
    hipError_t e = hipLaunchCooperativeKernel((const void*)fwd_kernel, dim3(grid), dim3(NWAVES * 64), args, LDS_BYTES, stream);
    if (e != hipSuccess) fprintf(stderr, "cooperative launch failed: %s (grid %d)\n", hipGetErrorString(e), grid);
#endif
}
```

```cpp
#include <hip/hip_runtime.h>
#include <hip/hip_cooperative_groups.h>
#include <cstdio>
#include <cstdint>
namespace cg = cooperative_groups;
__device__ __forceinline__ float xl32_add(float s) { const auto r = __builtin_amdgcn_permlane32_swap(__float_as_uint(s), __float_as_uint(s), false, false); return __uint_as_float(r[0]) + __uint_as_float(r[1]); }
__device__ __forceinline__ float xl16_add(float s) { const auto r = __builtin_amdgcn_permlane16_swap(__float_as_uint(s), __float_as_uint(s), false, false); return __uint_as_float(r[0]) + __uint_as_float(r[1]); }
__device__ __forceinline__ float xl32_max(float s) { const auto r = __builtin_amdgcn_permlane32_swap(__float_as_uint(s), __float_as_uint(s), false, false); return __builtin_fmaxf(__uint_as_float(r[0]), __uint_as_float(r[1])); }
namespace pg8 {
#define PG8_LAS __attribute__((address_space(3)))
typedef unsigned short bf16_t;
typedef short bf16x8 __attribute__((ext_vector_type(8)));
typedef float f32x4 __attribute__((ext_vector_type(4)));
typedef unsigned u32x4 __attribute__((ext_vector_type(4)));
constexpr int BM = 256, BK = 64, HALF = 128, HTB = HALF * BK * 2  , STAGE_BYTES = 8 * HTB, NXCD = 8, WGM = 8;

__host__ __device__ __forceinline__ int lds_byte(int r, int c) { const int st = (r >> 4) * 2 + (c >> 5), rr = r & 15, cc = c & 31, ob = rr * 64 + cc * 2; return st * 1024 + (ob ^ (((ob >> 9) & 1) << 5)); }
__host__ __device__ __forceinline__ void stage_rc(int b, int& R, int& C) { const int st = b / 1024, sb = b % 1024, swz = sb ^ (((sb >> 9) & 1) << 5); R = (st >> 1) * 16 + swz / 64; C = (st & 1) * 32 + (swz % 64) / 2; }
__host__ __device__ __forceinline__ int perm32(int rho) { const int n = rho >> 4, i = rho & 15; return 8 * (i >> 2) + 4 * n + (i & 3); }

struct Unit { int pm, pn; };
struct Gemm { const bf16_t* A; const bf16_t* Bt; int M, N, K; };

struct StaticOrder {
    int nM, nN, nwg, G, c, rev;
    __host__ __device__ void init(int M, int N, int G_, int c_) { nM = M / BM; nN = N / BM; nwg = nM * nN; G = G_; c = c_; rev = 0; }
    __host__ __device__ void reverse() { rev = (nwg % G == 0) ? nwg / G : 0; }
    __host__ __device__ bool next(int i, Unit& u) const {
        if (rev) { if (i >= rev) return false; i = rev - 1 - i; }
        const long L = (long)i * G + c; if (L >= nwg) return false;
        int wgid = (int)L; { const int q = nwg / NXCD, r = nwg % NXCD, xcd = wgid % NXCD, off = wgid / NXCD; wgid = (xcd < r ? xcd * (q + 1) : r * (q + 1) + (xcd - r) * q) + off; }
        const int nig = WGM * nN, gid = wgid / nig, fm = gid * WGM, gsz = (nM - fm) < WGM ? (nM - fm) : WGM;
        u.pm = fm + ((wgid % nig) % gsz); u.pn = (wgid % nig) / gsz; return true;
    }
    __device__ __forceinline__ void a_ready(const Unit&) const {}
    __device__ __forceinline__ void done(const Unit&) const {}
};

__device__ __forceinline__ unsigned cvt_pk_bf16(float lo, float hi) { unsigned r; asm volatile("v_cvt_pk_bf16_f32 %0, %1, %2" : "=v"(r) : "v"(lo), "v"(hi)); return r; }
typedef float f32x2 __attribute__((ext_vector_type(2)));
template <class Epi, class Sched, bool ALIGN_EPI = false, bool SP2 = false>
__device__ __forceinline__ void gemm_phase(PG8_LAS unsigned char* lds, const Gemm g, const Sched& S, const Epi& E) {
    int tid_ = threadIdx.x; asm volatile("" : "+v"(tid_));
    const int tid = tid_, wid = __builtin_amdgcn_readfirstlane(tid >> 6), lane = tid & 63, wr = wid >> 2, wc = wid & 3, fr = lane & 15, fq = lane >> 4;
    int K_ = g.K; asm volatile("" : "+s"(K_));
    const int K = K_, nt = K / BK;
    unsigned voffA[2], voffB[2];
#pragma unroll
    for (int i = 0; i < 2; ++i) { int R, C; stage_rc(tid * 16 + i * 8192, R, C); const int Rb = Epi::PERM ? ((R & ~31) + perm32(R & 31)) : R;
        voffA[i] = (unsigned)(R * K + C) * 2u; voffB[i] = (unsigned)(Rb * K + C) * 2u; }
    const size_t kstep = (size_t)(BK * 2);
    const size_t hstep = (size_t)HALF * K * 2;
    const size_t tstep = 2 * hstep;
    const unsigned ldsw = (unsigned)wid * 1024u;
    const int aoff = lds_byte(wr * 64 + fr, fq * 8), boff = lds_byte(wc * 32 + fr, fq * 8);
#define PG8_SA(b, h) (((b) * 2 + (h)) * HTB)
#define PG8_SB(b, h) ((4 + (b) * 2 + (h)) * HTB)
#define PG8_STAGE(bufoff, gbase, voff) do { _Pragma("unroll") for (int _i = 0; _i < 2; ++_i) \
        __builtin_amdgcn_global_load_lds((const unsigned*)((const char*)(gbase) + (voff)[_i]), (PG8_LAS unsigned*)(lds + (bufoff) + ldsw + _i * 8192), 16, 0, 0); } while (0)
#define PG8_LDA(dst, b, h) do { _Pragma("unroll") for (int m = 0; m < 4; ++m) _Pragma("unroll") for (int k = 0; k < 2; ++k) dst[m][k] = *(const PG8_LAS bf16x8*)(lds + PG8_SA(b, h) + aoff + m * 2048 + k * 1024); } while (0)
#define PG8_LDB(dst, b, h) do { _Pragma("unroll") for (int n = 0; n < 2; ++n) _Pragma("unroll") for (int k = 0; k < 2; ++k) dst[n][k] = *(const PG8_LAS bf16x8*)(lds + PG8_SB(b, h) + boff + n * 2048 + k * 1024); } while (0)
#define PG8_MMA(ai, bj, At, Bt) do { __builtin_amdgcn_s_setprio(1); _Pragma("unroll") for (int m = 0; m < 4; ++m) _Pragma("unroll") for (int n = 0; n < 2; ++n) _Pragma("unroll") for (int k = 0; k < 2; ++k) \
        acc[ai][bj][m][n] = __builtin_amdgcn_mfma_f32_16x16x32_bf16(Bt[n][k], At[m][k], acc[ai][bj][m][n], 0, 0, 0); __builtin_amdgcn_s_setprio(0); } while (0)
#define PG8_WAIT_V(n) asm volatile("s_waitcnt vmcnt(" #n ")" ::: "memory")
#define PG8_WAIT_L(n) asm volatile("s_waitcnt lgkmcnt(" #n ")" ::: "memory")
#define PG8_BAR __builtin_amdgcn_s_barrier()
#define PG8_SCHED __builtin_amdgcn_sched_barrier(0)
    Unit cur, nxt; int ui = 0;
    if (!S.next(0, cur)) return;
    f32x4 acc[2][2][4][2];
#pragma unroll
    for (int a = 0; a < 2; ++a)
#pragma unroll
        for (int b = 0; b < 2; ++b)
#pragma unroll
            for (int m = 0; m < 4; ++m)
#pragma unroll
                for (int n = 0; n < 2; ++n) acc[a][b][m][n] = (f32x4){0.f, 0.f, 0.f, 0.f};
    bf16x8 At[4][2], B0[2][2], B1[2][2];
    const char* cA = (const char*)g.A + (size_t)cur.pm * tstep; const char* cB = (const char*)g.Bt + (size_t)cur.pn * tstep;
    S.a_ready(cur);
    if constexpr (SP2) {
        PG8_STAGE(PG8_SB(0, 0), cB, voffB); PG8_STAGE(PG8_SB(0, 1), cB + hstep, voffB); PG8_STAGE(PG8_SA(0, 0), cA, voffA); PG8_STAGE(PG8_SA(0, 1), cA + hstep, voffA);
        if (wr == 1) PG8_BAR;
        PG8_WAIT_V(2); PG8_BAR;
        PG8_STAGE(PG8_SB(1, 0), cB + kstep, voffB); PG8_STAGE(PG8_SA(1, 0), cA + kstep, voffA); PG8_STAGE(PG8_SB(1, 1), cB + hstep + kstep, voffB);
        PG8_WAIT_V(6); PG8_BAR;
    } else {
        PG8_STAGE(PG8_SB(0, 0), cB, voffB); PG8_STAGE(PG8_SA(0, 0), cA, voffA); PG8_STAGE(PG8_SB(0, 1), cB + hstep, voffB); PG8_STAGE(PG8_SA(0, 1), cA + hstep, voffA);
        if (wr == 1) PG8_BAR;
        PG8_WAIT_V(4); PG8_BAR;
        PG8_STAGE(PG8_SB(1, 0), cB + kstep, voffB); PG8_STAGE(PG8_SA(1, 0), cA + kstep, voffA); PG8_STAGE(PG8_SB(1, 1), cB + hstep + kstep, voffB);
        PG8_WAIT_V(6); PG8_BAR;
    }
    for (;;) {
        const bool has_next = S.next(ui + 1, nxt);
        const char* nA = has_next ? (const char*)g.A + (size_t)nxt.pm * tstep : cA; const char* nB = has_next ? (const char*)g.Bt + (size_t)nxt.pn * tstep : cB;
        for (int t = 0; t < nt; t += 2) {
            const bool last = (t == nt - 2);
            const char* a1 = cA + (size_t)(t + 1) * kstep;
            const char* a2 = last ? nA : cA + (size_t)(t + 2) * kstep; const char* b2 = last ? nB : cB + (size_t)(t + 2) * kstep;
            const char* a3 = a2 + kstep; const char* b3 = b2 + kstep;
            if (last && has_next) S.a_ready(nxt);
            if constexpr (SP2) {
            PG8_LDB(B0, 0, 0); PG8_LDB(B1, 0, 1); PG8_SCHED; PG8_LDA(At, 0, 0); PG8_STAGE(PG8_SA(1, 1), a1 + hstep, voffA);
            PG8_WAIT_V(8); PG8_WAIT_L(0); PG8_BAR; PG8_MMA(0, 0, At, B0); PG8_MMA(0, 1, At, B1); PG8_BAR; PG8_SCHED;
            PG8_LDA(At, 0, 1); PG8_STAGE(PG8_SB(0, 0), b2, voffB); PG8_STAGE(PG8_SB(0, 1), b2 + hstep, voffB); PG8_STAGE(PG8_SA(0, 0), a2, voffA);
            PG8_WAIT_V(8); PG8_WAIT_L(0); PG8_BAR; PG8_MMA(1, 0, At, B0); PG8_MMA(1, 1, At, B1); PG8_BAR; PG8_SCHED;
            PG8_LDB(B0, 1, 0); PG8_LDB(B1, 1, 1); PG8_SCHED; PG8_LDA(At, 1, 0); PG8_STAGE(PG8_SA(0, 1), a2 + hstep, voffA);
            PG8_WAIT_V(8); PG8_WAIT_L(0); PG8_BAR; PG8_MMA(0, 0, At, B0); PG8_MMA(0, 1, At, B1); PG8_BAR; PG8_SCHED;
            PG8_LDA(At, 1, 1); PG8_STAGE(PG8_SB(1, 0), b3, voffB); PG8_STAGE(PG8_SB(1, 1), b3 + hstep, voffB); PG8_STAGE(PG8_SA(1, 0), a3, voffA);
            PG8_WAIT_V(8); PG8_WAIT_L(0); PG8_BAR; PG8_MMA(1, 0, At, B0); PG8_MMA(1, 1, At, B1); PG8_BAR; PG8_SCHED;
            } else {
            PG8_LDB(B0, 0, 0); PG8_SCHED; PG8_LDA(At, 0, 0); PG8_STAGE(PG8_SA(1, 1), a1 + hstep, voffA);
            PG8_WAIT_L(8); PG8_BAR; PG8_WAIT_L(0); PG8_MMA(0, 0, At, B0); PG8_BAR; PG8_SCHED;
            PG8_LDB(B1, 0, 1); PG8_STAGE(PG8_SB(0, 0), b2, voffB);
            PG8_BAR; PG8_WAIT_L(0); PG8_MMA(0, 1, At, B1); PG8_BAR;
            PG8_LDA(At, 0, 1); PG8_STAGE(PG8_SA(0, 0), a2, voffA);
            PG8_BAR; PG8_WAIT_L(0); PG8_MMA(1, 0, At, B0); PG8_BAR; PG8_SCHED;
            PG8_STAGE(PG8_SB(0, 1), b2 + hstep, voffB);
            PG8_WAIT_V(6); PG8_BAR; PG8_MMA(1, 1, At, B1); PG8_BAR;
            PG8_LDB(B0, 1, 0); PG8_SCHED; PG8_LDA(At, 1, 0); PG8_STAGE(PG8_SA(0, 1), a2 + hstep, voffA);
            PG8_WAIT_L(8); PG8_BAR; PG8_WAIT_L(0); PG8_MMA(0, 0, At, B0); PG8_BAR; PG8_SCHED;
            PG8_LDB(B1, 1, 1); PG8_STAGE(PG8_SB(1, 0), b3, voffB);
            PG8_BAR; PG8_WAIT_L(0); PG8_MMA(0, 1, At, B1); PG8_BAR;
            PG8_LDA(At, 1, 1); PG8_STAGE(PG8_SA(1, 0), a3, voffA);
            PG8_BAR; PG8_WAIT_L(0); PG8_MMA(1, 0, At, B0); PG8_BAR; PG8_SCHED;
            PG8_STAGE(PG8_SB(1, 1), b3 + hstep, voffB);
            PG8_WAIT_V(6); PG8_BAR; PG8_MMA(1, 1, At, B1); PG8_BAR;
            }
        }
        if constexpr (ALIGN_EPI) { if (wr == 0) PG8_BAR; }
        if constexpr (!Epi::AFTER_DRAIN) { E(acc, cur, wr, wc, fr, fq);
#if defined(EPI_REPS)
            if constexpr (Epi::IDEMP) { _Pragma("unroll 1") for (int rep_ = 1; rep_ < EPI_REPS; ++rep_) { asm volatile("" ::: "memory"); E(acc, cur, wr, wc, fr, fq); } }
#endif
            S.done(cur); }
        if (!has_next) break;
#pragma unroll
        for (int a = 0; a < 2; ++a)
#pragma unroll
            for (int b = 0; b < 2; ++b)
#pragma unroll
                for (int m = 0; m < 4; ++m)
#pragma unroll
                    for (int n = 0; n < 2; ++n) acc[a][b][m][n] = (f32x4){0.f, 0.f, 0.f, 0.f};
        cur = nxt; cA = nA; cB = nB; ++ui;
        if constexpr (ALIGN_EPI) { if (wr == 1) PG8_BAR; }
    }
    PG8_WAIT_V(0);
    if constexpr (!ALIGN_EPI) { if (wr == 0) PG8_BAR; }
    PG8_BAR;
    if constexpr (Epi::AFTER_DRAIN) { E.fused(acc, cur, wr, wc, fr, fq, lds, wid, lane); S.done(cur); }
#undef PG8_SA
#undef PG8_SB
#undef PG8_STAGE
#undef PG8_LDA
#undef PG8_LDB
#undef PG8_MMA
#undef PG8_WAIT_V
#undef PG8_WAIT_L
#undef PG8_BAR
#undef PG8_SCHED
}
}
namespace pg8 {
constexpr float QSCALE = 0.125f * 1.4426950408889634f;
constexpr float RMS_EPS = 1e-6f;
constexpr int MP_ROWS = 65536;
__device__ __forceinline__ float ss_sum(const float* ss, int row, int fq) { const f32x4 a = *(const f32x4*)(ss + (size_t)row * 16 + 4 * fq);
    float s = (a[0] + a[1]) + (a[2] + a[3]); s = xl16_add(s); s = xl32_add(s); return s; }
__device__ __forceinline__ f32x4 ss_load(const float* ss, int row, int fq) { return *(const f32x4*)(ss + (size_t)row * 16 + 4 * fq); }
__device__ __forceinline__ float rinv_from(const f32x4 a) { float s = (a[0] + a[1]) + (a[2] + a[3]); s = xl16_add(s); s = xl32_add(s); return __builtin_amdgcn_rsqf(s * (1.0f / 1024.0f) + RMS_EPS); }
#define SS_LOAD8(pa, ss, row0, fq) do { _Pragma("unroll") for (int i_ = 0; i_ < 8; ++i_) pa[i_] = ss_load(ss, (row0) + (i_ >> 2) * HALF + (i_ & 3) * 16, fq); \
    asm volatile("" : "+v"(pa[0]), "+v"(pa[1]), "+v"(pa[2]), "+v"(pa[3]), "+v"(pa[4]), "+v"(pa[5]), "+v"(pa[6]), "+v"(pa[7])); } while (0)
__device__ __forceinline__ float rinv_of(const float* ss, int row, int fq) { return __builtin_amdgcn_rsqf(ss_sum(ss, row, fq) * (1.0f / 1024.0f) + RMS_EPS); }
__device__ __forceinline__ float bf_lo(unsigned w) { return __uint_as_float(w << 16); }
__device__ __forceinline__ float bf_hi(unsigned w) { return __uint_as_float(w & 0xffff0000u); }

template <int MODE> struct EpiBf16R {
    static constexpr bool PERM = true, AFTER_DRAIN = false, IDEMP = true;
    bf16_t* O; int ldc; const float* ss;
    __device__ __forceinline__ void operator()(const f32x4 (&acc)[2][2][4][2], const Unit& u, int wr, int wc, int fr, int fq) const {
        const int row0 = u.pm * BM + wr * 64 + fr;
        const int colw = wc * 32 + 8 * fq;
        float sc = 1.f;
        if (MODE == 1) { if (u.pn < 4) sc = QSCALE; }
        float rsv[2][4];
        if (MODE != 0 && MODE != 2) {
            f32x4 pa[8]; SS_LOAD8(pa, ss, row0, fq);
#pragma unroll
            for (int i = 0; i < 8; ++i) rsv[i >> 2][i & 3] = sc * rinv_from(pa[i]);
        } else {
#pragma unroll
            for (int i = 0; i < 8; ++i) rsv[i >> 2][i & 3] = sc;
        }
#pragma unroll
        for (int ai = 0; ai < 2; ++ai)
#pragma unroll
            for (int m = 0; m < 4; ++m) {
                const int row = row0 + ai * HALF + m * 16;
                const float rs = rsv[ai][m];
                bf16_t* rowp = O + (size_t)row * ldc;
                if (MODE == 3 && u.pn >= 4) {
                    const f32x4 z0 = (acc[ai][0][m][0] * rs) * (acc[ai][1][m][0] * rs), z1 = (acc[ai][0][m][1] * rs) * (acc[ai][1][m][1] * rs);
                    u32x4 w; w.x = cvt_pk_bf16(z0[0], z0[1]); w.y = cvt_pk_bf16(z0[2], z0[3]); w.z = cvt_pk_bf16(z1[0], z1[1]); w.w = cvt_pk_bf16(z1[2], z1[3]);
                    *(u32x4*)(rowp + 1024 + (u.pn - 4) * HALF + colw) = w;
                } else {
#pragma unroll
                    for (int bj = 0; bj < 2; ++bj) {
                        f32x4 v0, v1;
                        if (MODE == 2) {
                            const f32x4 a0 = acc[ai][bj][m][0], a1 = acc[ai][bj][m][1]; f32x4 m0, m1;
#pragma unroll
                            for (int e = 0; e < 4; ++e) { m0[e] = fmaxf(a0[e], 0.f); m1[e] = fmaxf(a1[e], 0.f); }
                            v0 = a0 * m0; v1 = a1 * m1;
                        } else { v0 = acc[ai][bj][m][0] * rs; v1 = acc[ai][bj][m][1] * rs; }
                        u32x4 w; w.x = cvt_pk_bf16(v0[0], v0[1]); w.y = cvt_pk_bf16(v0[2], v0[3]); w.z = cvt_pk_bf16(v1[0], v1[1]); w.w = cvt_pk_bf16(v1[2], v1[3]);
                        *(u32x4*)(rowp + u.pn * BM + bj * HALF + colw) = w;
                    }
                }
            }
    }
};

template <int MODE> struct EpiResid {
    static constexpr bool PERM = true, AFTER_DRAIN = false, IDEMP = false;
    const bf16_t* xold; bf16_t* xnew; float* ss_next; const float* ss_cur; const bf16_t* T;
    __device__ __forceinline__ void operator()(const f32x4 (&acc)[2][2][4][2], const Unit& u, int wr, int wc, int fr, int fq) const {
        const int row0 = u.pm * BM + wr * 64 + fr;
        const int col0 = u.pn * BM + wc * 32 + 8 * fq;
        float rsv[2][4];
        if (MODE != 0) {
            f32x4 pa[8]; SS_LOAD8(pa, ss_cur, row0, fq);
#pragma unroll
            for (int i = 0; i < 8; ++i) { const float r = rinv_from(pa[i]); rsv[i >> 2][i & 3] = (MODE == 1) ? r * (-1.4426950408889634f) : r * r; }
        }
        constexpr int RB = (MODE == 1) ? 2 : 4;
#pragma unroll
        for (int g8 = 0; g8 < 8; g8 += RB) {
            u32x4 xo[RB][2], tt[RB][2];
#pragma unroll
            for (int k = 0; k < RB; ++k)
#pragma unroll
                for (int bj = 0; bj < 2; ++bj) { const int ai = (g8 + k) >> 2, m = (g8 + k) & 3; const size_t off = (size_t)(row0 + ai * HALF + m * 16) * 1024 + col0 + bj * HALF;
                    xo[k][bj] = *(const u32x4*)(xold + off); if (MODE == 1) tt[k][bj] = *(const u32x4*)(T + off); }
            if (RB == 4) asm volatile("" : "+v"(xo[0][0]), "+v"(xo[0][1]), "+v"(xo[1][0]), "+v"(xo[1][1]), "+v"(xo[RB - 2][0]), "+v"(xo[RB - 2][1]), "+v"(xo[RB - 1][0]), "+v"(xo[RB - 1][1]));
            else asm volatile("" : "+v"(xo[0][0]), "+v"(xo[0][1]), "+v"(xo[1][0]), "+v"(xo[1][1]), "+v"(tt[0][0]), "+v"(tt[0][1]), "+v"(tt[1][0]), "+v"(tt[1][1]));
#pragma unroll
            for (int k = 0; k < RB; ++k) {
                const int ai = (g8 + k) >> 2, m = (g8 + k) & 3;
                const int row = row0 + ai * HALF + m * 16;
                const size_t roff = (size_t)row * 1024 + col0;
                float sq = 0.f;
#pragma unroll
                for (int bj = 0; bj < 2; ++bj) {
                    const u32x4 xv = xo[k][bj];
                    f32x4 d0 = acc[ai][bj][m][0], d1 = acc[ai][bj][m][1];
                    if (MODE == 2) { d0 = d0 * rsv[ai][m]; d1 = d1 * rsv[ai][m]; }
                    if (MODE == 1) {
                        const float rs = rsv[ai][m];
                        const u32x4 t = tt[k][bj];
                        f32x4 t0, t1; t0[0] = bf_lo(t.x); t0[1] = bf_hi(t.x); t0[2] = bf_lo(t.y); t0[3] = bf_hi(t.y); t1[0] = bf_lo(t.z); t1[1] = bf_hi(t.z); t1[2] = bf_lo(t.w); t1[3] = bf_hi(t.w);
#pragma unroll
                        for (int e = 0; e < 4; ++e) {
                            d0[e] = t0[e] * __builtin_amdgcn_rcpf(1.0f + __builtin_amdgcn_exp2f(d0[e] * rs));
                            d1[e] = t1[e] * __builtin_amdgcn_rcpf(1.0f + __builtin_amdgcn_exp2f(d1[e] * rs));
                        }
                    }
                    f32x4 x0, x1; x0[0] = bf_lo(xv.x) + d0[0]; x0[1] = bf_hi(xv.x) + d0[1]; x0[2] = bf_lo(xv.y) + d0[2]; x0[3] = bf_hi(xv.y) + d0[3];
                    x1[0] = bf_lo(xv.z) + d1[0]; x1[1] = bf_hi(xv.z) + d1[1]; x1[2] = bf_lo(xv.w) + d1[2]; x1[3] = bf_hi(xv.w) + d1[3];
                    u32x4 w; w.x = cvt_pk_bf16(x0[0], x0[1]); w.y = cvt_pk_bf16(x0[2], x0[3]); w.z = cvt_pk_bf16(x1[0], x1[1]); w.w = cvt_pk_bf16(x1[2], x1[3]);
                    *(u32x4*)(xnew + roff + bj * HALF) = w;
                    sq += (x0[0] * x0[0] + x0[1] * x0[1]) + (x0[2] * x0[2] + x0[3] * x0[3]) + (x1[0] * x1[0] + x1[1] * x1[1]) + (x1[2] * x1[2] + x1[3] * x1[3]);
                }
                sq = xl16_add(sq); sq = xl32_add(sq);
                if (fq == 0) ss_next[(size_t)row * 16 + u.pn * 4 + wc] = sq;
            }
        }
    }
};
}
namespace attn {
#define ALAS __attribute__((address_space(3)))
typedef unsigned short bf16_t;
typedef short bf16x8 __attribute__((ext_vector_type(8)));
typedef short s16x4 __attribute__((ext_vector_type(4)));
typedef short v4i16_t __attribute__((ext_vector_type(4)));
typedef float f32x16 __attribute__((ext_vector_type(16)));
typedef unsigned u32x4 __attribute__((ext_vector_type(4)));
typedef unsigned u32x2 __attribute__((ext_vector_type(2)));
constexpr int QKV_LD = 1536, KOFF = 1024, VOFF = 1280, O_LD = 1024;
constexpr int BT_STRIDE = 320;
constexpr int LDS_K = 0, LDS_V = 49152, LDS_BT = 98304, LDS_BYTES = LDS_BT + 16 * BT_STRIDE * 4;
constexpr float THR = 8.0f;
__device__ __forceinline__ unsigned cvtpk(float lo, float hi) { unsigned r; asm volatile("v_cvt_pk_bf16_f32 %0, %1, %2" : "=v"(r) : "v"(lo), "v"(hi)); return r; }
__device__ __forceinline__ float max3f(float a, float b, float c) { return __builtin_fmaxf(__builtin_fmaxf(a, b), c); }

struct UnitPos { int rowbase, q0, S, g; };
__device__ __forceinline__ int slot_unit(int s, int stride, int nunits) {
    if ((stride & 7) || (nunits % stride)) return s;
    const int nk = nunits / stride, k0 = s / stride, b = s - k0 * stride, k = nk - 1 - k0;
    return (b & 7) * (nunits >> 3) + k * (stride >> 3) + (b >> 3);
}
__device__ __forceinline__ UnitPos unit_pos(int u) {
    UnitPos p; const int sb = u >> 2; p.g = u & 3;
    if (sb < 512) { p.rowbase = (sb >> 5) * 4096; p.q0 = (sb & 31) * 128; p.S = 4096; }
    else { const int t = sb - 512; p.rowbase = 65536 + (t >> 4) * 2048; p.q0 = (t & 15) * 128; p.S = 2048; }
    return p;
}
__device__ __forceinline__ void band_fetch(u32x4 (&kk)[6], const bf16_t* __restrict__ QKV, const UnitPos& P, int tid, int off) {
#pragma unroll
    for (int i = 0; i < 6; ++i) {
        const int chunk = tid + 512 * i, kvr = chunk >> 3, c = chunk & 7, pos = P.q0 - 128 + kvr;
        kk[i] = (u32x4){0u, 0u, 0u, 0u};
        if (pos >= 0 && pos < P.S) kk[i] = *(const u32x4*)(QKV + (size_t)(P.rowbase + pos) * QKV_LD + P.g * 64 + c * 8 + off);
    }
}
__device__ __forceinline__ void k_to_lds(ALAS unsigned char* lds, const u32x4 (&kk)[6], int tid) {
#pragma unroll
    for (int i = 0; i < 6; ++i) { const int chunk = tid + 512 * i, kvr = chunk >> 3, c = chunk & 7;
        *(ALAS u32x4*)(lds + LDS_K + kvr * 128 + ((c ^ ((kvr >> 1) & 7)) * 16)) = kk[i]; }
}
__device__ __forceinline__ void v_to_lds(ALAS unsigned char* lds, const u32x4 (&vv)[6], int tid) {
#pragma unroll
    for (int i = 0; i < 6; ++i) { const int chunk = tid + 512 * i, kvr = chunk >> 3, c = chunk & 7;
        *(ALAS u32x4*)(lds + LDS_V + (c >> 2) * 24576 + (kvr >> 3) * 512 + (kvr & 7) * 64 + (c & 3) * 16) = vv[i]; }
}

struct QState { f32x16 o0, o1; float mref, lrun; };
__device__ __forceinline__ void softmax_tile(f32x16& p, QState& Q, int ktp, int ql, int hi) {
    if (ktp == 0) {
#pragma unroll
        for (int r = 0; r < 16; ++r) { if ((r & 3) + 8 * (r >> 2) + 4 * hi < ql) p[r] = -INFINITY; }
    }
    if (ktp == 8) {
#pragma unroll
        for (int r = 0; r < 16; ++r) { if ((r & 3) + 8 * (r >> 2) + 4 * hi > ql) p[r] = -INFINITY; }
    }
    float tmax = max3f(max3f(p[0], p[1], p[2]), max3f(p[3], p[4], p[5]), max3f(p[6], p[7], p[8]));
    tmax = max3f(tmax, max3f(p[9], p[10], p[11]), max3f(p[12], p[13], p[14])); tmax = __builtin_fmaxf(tmax, p[15]);
    tmax = xl32_max(tmax);
    if (__builtin_expect(__any(tmax > THR), 0)) {
        const float dl = tmax > THR ? tmax : 0.f;
        Q.mref += dl;
        const float f = __builtin_amdgcn_exp2f(-dl);
        Q.lrun *= f;
#pragma unroll
        for (int r = 0; r < 16; ++r) { p[r] -= dl; Q.o0[r] *= f; Q.o1[r] *= f; }
    }
    float psum = 0.f;
#pragma unroll
    for (int r = 0; r < 16; ++r) { p[r] = __builtin_amdgcn_exp2f(p[r]); psum += p[r]; }
    Q.lrun += psum;
}
__device__ __forceinline__ bf16x8 pack_p(const f32x16& p, int s) {
    u32x4 pw; pw.x = cvtpk(p[8 * s + 0], p[8 * s + 1]); pw.y = cvtpk(p[8 * s + 2], p[8 * s + 3]); pw.z = cvtpk(p[8 * s + 4], p[8 * s + 5]); pw.w = cvtpk(p[8 * s + 6], p[8 * s + 7]);
    return __builtin_bit_cast(bf16x8, pw);
}
__device__ __forceinline__ f32x16 qk_tile(const bf16x8 (&q)[4], const QState& Q, const ALAS unsigned char* kbase, const ALAS float* bt, int kt, int ktp, int ql, int hi) {
    const int kvr = kt * 32 + ql;
    const ALAS unsigned char* krow = kbase + kvr * 128;
    const int ksw = (kvr >> 1) & 7;
    bf16x8 kf[4];
#pragma unroll
    for (int ds = 0; ds < 4; ++ds) kf[ds] = *(const ALAS bf16x8*)(krow + (((2 * ds + hi) ^ ksw) * 16));
    f32x16 p; const ALAS float* bp = bt + (32 + 32 * ktp - ql + 4 * hi);
#pragma unroll
    for (int r = 0; r < 16; ++r) p[r] = bp[(r & 3) + 8 * (r >> 2)];
    if (__builtin_expect(__any(Q.mref != 0.f), 0)) {
#pragma unroll
        for (int r = 0; r < 16; ++r) p[r] -= Q.mref; }
#pragma unroll
    for (int ds = 0; ds < 4; ++ds) p = __builtin_amdgcn_mfma_f32_32x32x16_bf16(kf[ds], q[ds], p, 0, 0, 0);
    return p;
}
__device__ __forceinline__ void softmax_pipe(f32x16& p, f32x16& pn, bool has_next, QState& Q, int ktp, int ql, int hi) {
    if (ktp == 0) {
#pragma unroll
        for (int r = 0; r < 16; ++r) { if ((r & 3) + 8 * (r >> 2) + 4 * hi < ql) p[r] = -INFINITY; }
    }
    if (ktp == 8) {
#pragma unroll
        for (int r = 0; r < 16; ++r) { if ((r & 3) + 8 * (r >> 2) + 4 * hi > ql) p[r] = -INFINITY; }
    }
    float tmax = max3f(max3f(p[0], p[1], p[2]), max3f(p[3], p[4], p[5]), max3f(p[6], p[7], p[8]));
    tmax = max3f(tmax, max3f(p[9], p[10], p[11]), max3f(p[12], p[13], p[14])); tmax = __builtin_fmaxf(tmax, p[15]);
    tmax = xl32_max(tmax);
    if (__builtin_expect(__any(tmax > THR), 0)) {
        const float dl = tmax > THR ? tmax : 0.f;
        Q.mref += dl;
        const float f = __builtin_amdgcn_exp2f(-dl);
        Q.lrun *= f;
#pragma unroll
        for (int r = 0; r < 16; ++r) { p[r] -= dl; Q.o0[r] *= f; Q.o1[r] *= f; }
        if (has_next) {
#pragma unroll
            for (int r = 0; r < 16; ++r) pn[r] -= dl; }
    }
    float psum = 0.f;
#pragma unroll
    for (int r = 0; r < 16; ++r) { p[r] = __builtin_amdgcn_exp2f(p[r]); psum += p[r]; }
    Q.lrun += psum;
}
__device__ __forceinline__ void pv_tile(QState& Q, const f32x16& p, const s16x4 (&vr)[2][4]) {
#pragma unroll
    for (int s = 0; s < 2; ++s) {
        const bf16x8 vf0 = (bf16x8){vr[s][0][0], vr[s][0][1], vr[s][0][2], vr[s][0][3], vr[s][1][0], vr[s][1][1], vr[s][1][2], vr[s][1][3]};
        const bf16x8 vf1 = (bf16x8){vr[s][2][0], vr[s][2][1], vr[s][2][2], vr[s][2][3], vr[s][3][0], vr[s][3][1], vr[s][3][2], vr[s][3][3]};
        const bf16x8 pf = pack_p(p, s);
        Q.o0 = __builtin_amdgcn_mfma_f32_32x32x16_bf16(vf0, pf, Q.o0, 0, 0, 0); Q.o1 = __builtin_amdgcn_mfma_f32_32x32x16_bf16(vf1, pf, Q.o1, 0, 0, 0);
    }
}
__device__ __forceinline__ void v_frags(s16x4 (&vr)[2][4], ALAS unsigned char* lds, int kt, int vlane) {
#pragma unroll
    for (int s = 0; s < 2; ++s) {
        const ALAS unsigned char* vp = lds + LDS_V + (4 * kt + 2 * s) * 512 + vlane;
        vr[s][0] = __builtin_bit_cast(s16x4, __builtin_amdgcn_ds_read_tr16_b64_v4i16((ALAS v4i16_t*)(vp)));
        vr[s][1] = __builtin_bit_cast(s16x4, __builtin_amdgcn_ds_read_tr16_b64_v4i16((ALAS v4i16_t*)(vp + 512)));
        vr[s][2] = __builtin_bit_cast(s16x4, __builtin_amdgcn_ds_read_tr16_b64_v4i16((ALAS v4i16_t*)(vp + 24576)));
        vr[s][3] = __builtin_bit_cast(s16x4, __builtin_amdgcn_ds_read_tr16_b64_v4i16((ALAS v4i16_t*)(vp + 24576 + 512)));
    }
}
__device__ __forceinline__ void run_qtile(QState& Q, const bf16x8 (&q)[4], const ALAS unsigned char* kbase, const ALAS float* bt, ALAS unsigned char* lds, int ot, int k0, int k1, int ql, int hi, int vlane) {
    f32x16 pa = qk_tile(q, Q, kbase, bt, k0, k0 - ot, ql, hi), pb = pa;
    int kt = k0;
    for (;;) {
        { s16x4 vr[2][4]; v_frags(vr, lds, kt, vlane);
          const bool nx = kt < k1;
          if (nx) pb = qk_tile(q, Q, kbase, bt, kt + 1, kt + 1 - ot, ql, hi);
          __builtin_amdgcn_sched_barrier(0);
          softmax_pipe(pa, pb, nx, Q, kt - ot, ql, hi);
          pv_tile(Q, pa, vr);
          if (!nx) break; ++kt; }
        { s16x4 vr[2][4]; v_frags(vr, lds, kt, vlane);
          const bool nx = kt < k1;
          if (nx) pa = qk_tile(q, Q, kbase, bt, kt + 1, kt + 1 - ot, ql, hi);
          __builtin_amdgcn_sched_barrier(0);
          softmax_pipe(pb, pa, nx, Q, kt - ot, ql, hi);
          pv_tile(Q, pb, vr);
          if (!nx) break; ++kt; }
    }
}
typedef float f32x2_t __attribute__((ext_vector_type(2))); typedef __bf16 bf16x2_t __attribute__((ext_vector_type(2)));
__device__ __forceinline__ unsigned cvtpk_c(float lo, float hi) { f32x2_t v = {lo, hi}; bf16x2_t b = __builtin_convertvector(v, bf16x2_t); return __builtin_bit_cast(unsigned, b); }
__device__ __forceinline__ void store_o(const QState& Q, bf16_t* __restrict__ O, int row, int h, int hi) {
    const float ltot = xl32_add(Q.lrun);
    const float inv = 1.0f / ltot;
    bf16_t* obase = O + (size_t)row * O_LD + h * 64 + 8 * hi;
    u32x2 w0[4], w1[4];
#pragma unroll
    for (int rg = 0; rg < 4; ++rg) {
        w0[rg].x = cvtpk_c(Q.o0[4 * rg] * inv, Q.o0[4 * rg + 1] * inv); w0[rg].y = cvtpk_c(Q.o0[4 * rg + 2] * inv, Q.o0[4 * rg + 3] * inv);
        w1[rg].x = cvtpk_c(Q.o1[4 * rg] * inv, Q.o1[4 * rg + 1] * inv); w1[rg].y = cvtpk_c(Q.o1[4 * rg + 2] * inv, Q.o1[4 * rg + 3] * inv);
    }
#pragma unroll
    for (int k = 0; k < 4; k += 2) {
        { const auto rx = __builtin_amdgcn_permlane32_swap(w0[k].x, w0[k + 1].x, false, false), ry = __builtin_amdgcn_permlane32_swap(w0[k].y, w0[k + 1].y, false, false);
          *(u32x4*)(obase + 8 * k) = (u32x4){rx[0], ry[0], rx[1], ry[1]}; }
        { const auto rx = __builtin_amdgcn_permlane32_swap(w1[k].x, w1[k + 1].x, false, false), ry = __builtin_amdgcn_permlane32_swap(w1[k].y, w1[k + 1].y, false, false);
          *(u32x4*)(obase + 32 + 8 * k) = (u32x4){rx[0], ry[0], rx[1], ry[1]}; }
    }
}

__device__ __forceinline__ void attn_phase(ALAS unsigned char* lds, const bf16_t* __restrict__ QKV, bf16_t* __restrict__ O, const float* __restrict__ biasg, const float* __restrict__ sink2,
                                           int first, int stride, int nunits) {
    int tid_ = threadIdx.x; asm volatile("" : "+v"(tid_));
    const int tid = tid_, lane = tid & 63, ql = lane & 31, hi = lane >> 5;
    const int wid = __builtin_amdgcn_readfirstlane(tid >> 6);
    const int r4 = wid >> 1, qh = wid & 1;
    for (int i = tid; i < 16 * BT_STRIDE; i += 512) ((ALAS float*)(lds + LDS_BT))[i] = biasg[i] - sink2[i / BT_STRIDE];
    const ALAS unsigned char* kbase = lds + LDS_K;
    const int vlane = (4 * hi + ((lane & 15) >> 2)) * 64 + ((lane >> 4) & 1) * 32 + (lane & 3) * 8;
    u32x4 pk[6], pv[6];
    if (first < nunits) { const UnitPos P0 = unit_pos(slot_unit(first, stride, nunits)); band_fetch(pk, QKV, P0, tid, KOFF); band_fetch(pv, QKV, P0, tid, VOFF); }
    for (int u = first; u < nunits; u += stride) {
        const UnitPos P = unit_pos(slot_unit(u, stride, nunits));
        const int h = P.g * 4 + r4;
        const int R0 = P.rowbase + P.q0 + qh * 64;
        bf16x8 qr[2][4];
#pragma unroll
        for (int qt = 0; qt < 2; ++qt)
#pragma unroll
            for (int ds = 0; ds < 4; ++ds) qr[qt][ds] = *(const bf16x8*)(QKV + (size_t)(R0 + qt * 32 + ql) * QKV_LD + h * 64 + ds * 16 + hi * 8);
        __syncthreads();
        k_to_lds(lds, pk, tid); v_to_lds(lds, pv, tid);
        __syncthreads();
        if (u + stride < nunits) { const UnitPos Pn = unit_pos(slot_unit(u + stride, stride, nunits)); band_fetch(pk, QKV, Pn, tid, KOFF); band_fetch(pv, QKV, Pn, tid, VOFF); }
        const ALAS float* bt = (const ALAS float*)(lds + LDS_BT) + h * BT_STRIDE;
        const int ktlo = (P.q0 == 0) ? 4 : 0, kthi = (P.q0 + 128 >= P.S) ? 7 : 11;
#pragma unroll
        for (int qt = 0; qt < 2; ++qt) {
            const int ot = qh * 2 + qt;
            int k0 = ot, k1 = ot + 8; if (k0 < ktlo) k0 = ktlo; if (k1 > kthi) k1 = kthi;
            QState Q; Q.mref = 0.f; Q.lrun = (hi == 0) ? 1.0f : 0.0f;
#pragma unroll
            for (int r = 0; r < 16; ++r) { Q.o0[r] = 0.f; Q.o1[r] = 0.f; }
            run_qtile(Q, qr[qt], kbase, bt, lds, ot, k0, k1, ql, hi, vlane);
            store_o(Q, O, R0 + qt * 32 + ql, h, hi);
        }
    }
    __syncthreads();
}
}
constexpr int NWAVES = 8;
constexpr int D = 1024, FF = 4096, PLE = 256, DEPTH = 4;
constexpr int MP = 65536, MS = 16384, M = MP + MS;
constexpr int SEQ_P = 4096, SEQ_S = 2048;
constexpr int NQKV = 1536, NCIN = 3072;
constexpr size_t MiB = 1u << 20;
constexpr size_t WS_BIAS = 0;
constexpr size_t WS_SINK = 32 * 1024;
constexpr size_t WS_BAR = 64 * 1024, WS_BAR_BYTES = 16 * 1024;
constexpr int MISC_OFF = 131072 + 320;
constexpr size_t WS_SS = 948 * MiB;
constexpr size_t WS_W = 8 * MiB;
constexpr size_t WS_XB = 108 * MiB;
constexpr size_t WS_PB = 268 * MiB;
constexpr size_t WS_H = 308 * MiB;
constexpr size_t SLOT = 160 * MiB;
constexpr size_t WS_END = WS_H + 4 * SLOT + 12 * MiB;
constexpr size_t W_QKV = 0;
constexpr size_t W_O = W_QKV + 2ull * NQKV * D;
constexpr size_t W_CIN = W_O + 2ull * D * D;
constexpr size_t W_COUT = W_CIN + 2ull * NCIN * D;
constexpr size_t W_UP = W_COUT + 2ull * D * D;
constexpr size_t W_DN = W_UP + 4ull * FF * D;
constexpr size_t W_G = W_DN + 4ull * FF * D;
constexpr size_t W_P = W_G + 4ull * D * D;
constexpr size_t W_TOTAL = W_P + 4ull * D * PLE;
static_assert(W_TOTAL * 2 <= 100 * MiB, "weight region");
constexpr int N_PHASES_C = 1 + 6 * 4 + 1;
constexpr int LDS_BYTES = 147456;
static_assert(pg8::STAGE_BYTES <= 131072 && attn::LDS_BYTES <= 131072, "LDS map");

#define LAS __attribute__((address_space(3)))
typedef unsigned short bf16;
typedef unsigned v4u __attribute__((ext_vector_type(4)));
typedef unsigned v2u __attribute__((ext_vector_type(2)));
typedef float f32x4 __attribute__((ext_vector_type(4)));
__device__ __forceinline__ unsigned f2bf(float f) { unsigned u = __builtin_bit_cast(unsigned, f); return (u + 0x7fffu + ((u >> 16) & 1u)) >> 16; }
__device__ __forceinline__ unsigned pk2(float lo, float hi) { return f2bf(lo) | (f2bf(hi) << 16); }
__device__ __forceinline__ float wave_sum(float v) {
#pragma unroll
    for (int o = 1; o < 64; o <<= 1) v += __shfl_xor(v, o);
    return v;
}

#define XB_TMO      128
#define XB_XCNT(j)  (256  + 64 * (j))
#define XB_XSUB(j)  (1280 + 64 * (j))
#define XB_XGEN(j)  (2304 + 64 * (j))
#define XB_TOP      3328
#define XB_TOPGEN   3392
#define XCD_BAR_WORDS 3456
#define XB_SPIN_CAP (1u << 18)

__device__ __forceinline__ unsigned xb_ld(unsigned* p)              { return __hip_atomic_load(p, __ATOMIC_RELAXED, __HIP_MEMORY_SCOPE_AGENT); }
__device__ __forceinline__ unsigned xb_add(unsigned* p, unsigned v) { return __hip_atomic_fetch_add(p, v, __ATOMIC_RELAXED, __HIP_MEMORY_SCOPE_AGENT); }
__device__ __forceinline__ unsigned xb_xcc_id() { return (unsigned)__builtin_amdgcn_s_getreg((3 << 11) | 20) & 0xFu; }
#define XB_SPIN(cond, bar) do { unsigned _sp = 0; while (cond) { __builtin_amdgcn_s_sleep(1); \
    if ((++_sp & 255u) == 0u) { if (xb_ld(&(bar)[XB_TMO])) break; if (_sp > XB_SPIN_CAP) { atomicAdd(&(bar)[XB_TMO], 1u); break; } } } } while (0)

struct XcdBarrier {
    unsigned* bar; unsigned x;
    volatile LAS unsigned* st;
};

__device__ __forceinline__ XcdBarrier xcd_barrier_post(unsigned* bar, volatile LAS unsigned* st) {
    XcdBarrier b; b.bar = bar; b.x = xb_xcc_id(); b.st = st;
    if (threadIdx.x == 0) (void)xb_add(&bar[XB_XCNT(b.x)], 1u);
    return b;
}
__device__ __forceinline__ void xcd_barrier_complete(unsigned* bar, unsigned x, unsigned& nloc, unsigned& nx) {
    const unsigned G = gridDim.x * gridDim.y * gridDim.z;
    unsigned sum, cnt, mine, sp = 0u;
    for (;;) {
        sum = 0u; cnt = 0u; mine = 0u;
#pragma unroll
        for (unsigned j = 0; j < 16; ++j) { const unsigned c = xb_ld(&bar[XB_XCNT(j)]); sum += c; cnt += (c > 0u) ? 1u : 0u; mine = (j == x) ? c : mine; }
        if (sum == G) break;
        __builtin_amdgcn_s_sleep(1);
        if ((++sp & 255u) == 0u) { if (xb_ld(&bar[XB_TMO])) break; if (sp > XB_SPIN_CAP) { atomicAdd(&bar[XB_TMO], 1u); break; } }
    }
    nloc = mine > 0u ? mine : 1u; nx = cnt > 0u ? cnt : 1u;
}

__device__ __forceinline__ void xcd_barrier(const XcdBarrier& b) {
    asm volatile("s_waitcnt vmcnt(0)" ::: "memory");
    __syncthreads();
    if (threadIdx.x == 0) {
        unsigned* bar = b.bar;
        __builtin_amdgcn_s_waitcnt(0);
        unsigned nloc = b.st[0], nx = b.st[1];
        if (nloc == 0u) { xcd_barrier_complete(bar, b.x, nloc, nx); b.st[0] = nloc; b.st[1] = nx; }
        const unsigned old = xb_add(&bar[XB_XSUB(b.x)], 1u);
        const unsigned gen = old / nloc;
        if (old + 1u == (gen + 1u) * nloc) {
            __builtin_amdgcn_fence(__ATOMIC_RELEASE, "agent");
            asm volatile("s_waitcnt vmcnt(0)" ::: "memory");
            const unsigned og = xb_add(&bar[XB_TOP], 1u);
            const unsigned tg = og / nx;
            if (og + 1u == (tg + 1u) * nx) xb_add(&bar[XB_TOPGEN], 1u);
            else XB_SPIN(xb_ld(&bar[XB_TOPGEN]) == tg, bar);
            __builtin_amdgcn_fence(__ATOMIC_ACQUIRE, "agent");
            xb_add(&bar[XB_XGEN(b.x)], 1u);
            asm volatile("s_waitcnt vmcnt(0)" ::: "memory");
        } else {
            XB_SPIN(xb_ld(&bar[XB_XGEN(b.x)]) == gen, bar);
            __builtin_amdgcn_fence(__ATOMIC_ACQUIRE, "agent");
            asm volatile("s_waitcnt vmcnt(0)" ::: "memory");
        }
    }
    __syncthreads();
}

struct Args {
    const float* in[19];
    float* out; unsigned char* ws;
    int ph_lo, ph_hi;
};

__device__ __forceinline__ int cin_row(int n) { if (n < 1024) return n; if (n < 2048) { const int c = n - 1024; return 1024 + (c >> 7) * 256 + (c & 127); } const int c = n - 2048; return 1024 + (c >> 7) * 256 + 128 + (c & 127); }
__device__ __forceinline__ void transpose_item(const float* __restrict__ W, int K, int N, bf16* __restrict__ WT, const float* __restrict__ gk, int mode, LAS float* scr, int item, int lane) {
    const int nblk = N / 32, kb = item / nblk, nb = item % nblk, k0 = 64 * kb, n0 = 32 * nb;
    float wv[32];
#pragma unroll
    for (int i = 0; i < 32; ++i) wv[i] = W[(size_t)(k0 + 2 * i + (lane >> 5)) * N + n0 + (lane & 31)];
#pragma unroll
    for (int i = 0; i < 32; ++i) { const int kk = 2 * i + (lane >> 5); float v = wv[i]; if (gk) v *= gk[k0 + kk]; scr[kk * 33 + (lane & 31)] = v; }
    asm volatile("s_waitcnt lgkmcnt(0)" ::: "memory");
    const int c = lane & 7;
    const int r0 = mode ? cin_row(n0) : n0;
#pragma unroll
    for (int j = 0; j < 4; ++j) { const int n = (lane >> 3) + 8 * j; const LAS float* s = scr + (8 * c) * 33 + n;
        v4u o; o.x = pk2(s[0 * 33], s[1 * 33]); o.y = pk2(s[2 * 33], s[3 * 33]); o.z = pk2(s[4 * 33], s[5 * 33]); o.w = pk2(s[6 * 33], s[7 * 33]);
        *(v4u*)(WT + (size_t)(r0 + n) * K + k0 + 8 * c) = o; }
    asm volatile("s_waitcnt lgkmcnt(0)" ::: "memory");
}

__device__ __forceinline__ int row_of(int v, bool descending) { const int vg = v / 16384, rem = v - vg * 16384, g = descending ? 4 - vg : vg; return ((rem >> 11) * 40 + g * 8) * 256 + (rem & 2047); }
__device__ __forceinline__ int t5_bucket(int rel) {
    const int n = rel < 0 ? -rel : rel; int b;
    if (n < 8) b = n; else { b = 8 + (n >= 12) + (n >= 16) + (n >= 23) + (n >= 32) + (n >= 46) + (n >= 64) + (n >= 91); if (b > 15) b = 15; }
    return (rel > 0 ? 16 : 0) + b;
}

__global__ void __launch_bounds__(NWAVES * 64, 2) fwd_kernel(Args a) {
    extern __shared__ __attribute__((aligned(16))) unsigned char lds_raw[];
    LAS unsigned char* lds = (LAS unsigned char*)lds_raw;
    cg::grid_group grid = cg::this_grid();
    const int G = gridDim.x, bx = blockIdx.x;
    if (threadIdx.x < 32) ((volatile LAS unsigned*)(lds + MISC_OFF))[threadIdx.x] = 0u;
    __syncthreads();
    const XcdBarrier xbar = xcd_barrier_post((unsigned*)(a.ws + WS_BAR), (volatile LAS unsigned*)(lds + MISC_OFF) + 8);
    const int NGW = G * NWAVES, NGT = G * NWAVES * 64;
#define TID_LOCALS() int tid_ = threadIdx.x; asm volatile("" : "+v"(tid_)); const int tid = tid_, lane = tid & 63, wave = __builtin_amdgcn_readfirstlane(tid >> 6), gw = bx * NWAVES + wave, gt = bx * (NWAVES * 64) + tid; (void)lane; (void)gw; (void)gt;
    unsigned char* ws = a.ws;
    const float* x_prompt = a.in[0]; const float* x_sample = a.in[1]; const float* p_prompt = a.in[2]; const float* p_sample = a.in[3];
    const float* rel_bias = a.in[4]; const float* attn_w_qkv = a.in[5]; const float* attn_w_o = a.in[6]; const float* attn_sink = a.in[7];
    const float* conv_w_in = a.in[8]; const float* conv_w = a.in[9]; const float* conv_w_out = a.in[10]; const float* mlp_w_up = a.in[11];
    const float* mlp_w_down = a.in[12]; const float* ple_w_gate = a.in[13]; const float* ple_w_proj = a.in[14];
    const float* norm_mix = a.in[15]; const float* norm_mlp = a.in[16]; const float* norm_ple = a.in[17]; const float* final_norm = a.in[18];
    float* out = a.out;
    float* biasg = (float*)(ws + WS_BIAS); float* sink2 = (float*)(ws + WS_SINK); float* SS = (float*)(ws + WS_SS);
    bf16* Wb = (bf16*)(ws + WS_W); bf16* XBm = (bf16*)(ws + WS_XB); bf16* PB = (bf16*)(ws + WS_PB);
    bf16* S0 = (bf16*)(ws + WS_H); bf16* S2 = (bf16*)(ws + WS_H + 2 * SLOT); bf16* S3 = (bf16*)(ws + WS_H + 3 * SLOT);
    const int lo = a.ph_lo, hi = a.ph_hi;
    int ph = 0;
#define IN_PH() (lo <= ph && ph < hi)
#ifndef SEAM_REPS
#define SEAM_REPS 1
#endif
#ifndef ATTN_REPS
#define ATTN_REPS 1
#endif
#ifndef UP_REPS
#define UP_REPS 1
#endif
#define SEAM() do { if (lo <= ph && ph + 1 < hi) { T_BEGIN(); _Pragma("unroll 1") for (int rep_ = 0; rep_ < SEAM_REPS; ++rep_) { if (ph == 0) { asm volatile("s_waitcnt vmcnt(0) lgkmcnt(0)" ::: "memory"); grid.sync(); __builtin_amdgcn_fence(__ATOMIC_ACQUIRE, "agent"); asm volatile("s_waitcnt vmcnt(0)" ::: "memory"); } else { xcd_barrier(xbar); } } T_END(3); } ++ph; } while (0)

#if defined(PROBE_A)
    unsigned long long tA = 0, tB = 0, tS = 0;
#define T_BEGIN() do { tS = __builtin_amdgcn_s_memrealtime(); } while (0)
#define T_END(cat) do { const unsigned long long d_ = __builtin_amdgcn_s_memrealtime() - tS; if ((cat) == PROBE_A) tA += d_; if ((cat) == PROBE_B) tB += d_; } while (0)
#else
#define T_BEGIN() do { } while (0)
#define T_END(cat) do { } while (0)
#endif
    if (IN_PH()) {
        T_BEGIN();
        TID_LOCALS();
        LAS float* scr = (LAS float*)(lds + wave * 16384);
#ifndef PRO_REPS
#define PRO_REPS 1
#endif
#pragma unroll 1
        for (int rep = 0; rep < PRO_REPS; ++rep) {
        constexpr int I_QKV = 16 * 48, I_CIN = 16 * 96, I_SQ = 16 * 32, I_UP = 16 * 128, I_DN = 64 * 32, I_P = 4 * 32;
        constexpr int L_EVEN = I_QKV + I_SQ + I_UP + I_DN + I_SQ + I_P, L_ODD = I_CIN + I_SQ + I_UP + I_DN + I_SQ + I_P;
        constexpr int NITEMS = 2 * (L_EVEN + L_ODD);
        for (int it = gw; it < NITEMS; it += NGW) {
            int r = it; const int pair = r / (L_EVEN + L_ODD); r -= pair * (L_EVEN + L_ODD);
            int i = 2 * pair; if (r >= L_EVEN) { r -= L_EVEN; i += 1; }
            const int j = pair; const bool odd = i & 1;
            const int I_IN = odd ? I_CIN : I_QKV;
            if (r < I_IN) {
                if (odd) transpose_item(conv_w_in + (size_t)j * D * NCIN, D, NCIN, Wb + W_CIN + (size_t)j * NCIN * D, norm_mix + i * D, 1, scr, r, lane);
                else transpose_item(attn_w_qkv + (size_t)j * D * NQKV, D, NQKV, Wb + W_QKV + (size_t)j * NQKV * D, norm_mix + i * D, 0, scr, r, lane);
                continue; }
            r -= I_IN;
            if (r < I_SQ) {
                if (odd) transpose_item(conv_w_out + (size_t)j * D * D, D, D, Wb + W_COUT + (size_t)j * D * D, nullptr, 0, scr, r, lane);
                else transpose_item(attn_w_o + (size_t)j * D * D, D, D, Wb + W_O + (size_t)j * D * D, nullptr, 0, scr, r, lane);
                continue; }
            r -= I_SQ;
            if (r < I_UP) { transpose_item(mlp_w_up + (size_t)i * D * FF, D, FF, Wb + W_UP + (size_t)i * FF * D, norm_mlp + i * D, 0, scr, r, lane); continue; }
            r -= I_UP;
            if (r < I_DN) { transpose_item(mlp_w_down + (size_t)i * FF * D, FF, D, Wb + W_DN + (size_t)i * D * FF, nullptr, 0, scr, r, lane); continue; }
            r -= I_DN;
            if (r < I_SQ) { transpose_item(ple_w_gate + (size_t)i * D * D, D, D, Wb + W_G + (size_t)i * D * D, norm_ple + i * D, 0, scr, r, lane); continue; }
            r -= I_SQ;
            transpose_item(ple_w_proj + (size_t)i * PLE * D, PLE, D, Wb + W_P + (size_t)i * D * PLE, nullptr, 0, scr, r, lane);
        }
        for (int v0 = gw; v0 < M; v0 += 2 * NGW) {
            const int m = row_of(v0, true), m2 = row_of((v0 + NGW < M) ? v0 + NGW : v0, true);
            const float* xr = (m < MP) ? x_prompt + (size_t)m * D : x_sample + (size_t)(m - MP) * D;
            const float* xr2 = (m2 < MP) ? x_prompt + (size_t)m2 * D : x_sample + (size_t)(m2 - MP) * D;
            const f32x4* x4 = (const f32x4*)xr + lane; const f32x4* y4 = (const f32x4*)xr2 + lane; float s = 0.f, s2 = 0.f; f32x4 v[4], w4[4];
#pragma unroll
            for (int j = 0; j < 4; ++j) { v[j] = x4[64 * j]; w4[j] = y4[64 * j]; }
#pragma unroll
            for (int j = 0; j < 4; ++j) { s += (v[j].x * v[j].x + v[j].y * v[j].y) + (v[j].z * v[j].z + v[j].w * v[j].w); s2 += (w4[j].x * w4[j].x + w4[j].y * w4[j].y) + (w4[j].z * w4[j].z + w4[j].w * w4[j].w); }
            s = wave_sum(s); s2 = wave_sum(s2);
            v2u* o8 = (v2u*)(S3 + (size_t)m * D) + lane; v2u* p8 = (v2u*)(S3 + (size_t)m2 * D) + lane;
#pragma unroll
            for (int j = 0; j < 4; ++j) { v2u w; w.x = pk2(v[j].x, v[j].y); w.y = pk2(v[j].z, v[j].w); o8[64 * j] = w; v2u z; z.x = pk2(w4[j].x, w4[j].y); z.y = pk2(w4[j].z, w4[j].w); p8[64 * j] = z; }
            if (lane < 16) { SS[(size_t)m * 16 + lane] = (lane == 0) ? s : 0.f; SS[(size_t)m2 * 16 + lane] = (lane == 0) ? s2 : 0.f; }
        }
        for (int i = gt; i < 16 * 320; i += NGT) {
            const int h = i / 320, e = i % 320, t = e - 32; float v = 0.f;
            if (t >= 0 && t <= 256) v = rel_bias[t5_bucket(t - 128) * 16 + h] * 1.4426950408889634f;
            biasg[i] = v;
        }
        if (gt < 32) sink2[gt] = attn_sink[gt] * 1.4426950408889634f;
        }
        T_END(4);
    }
    SEAM();

#pragma unroll 1
    for (int i = 0; i < DEPTH; ++i) {
        const int j = i >> 1; const bool odd = i & 1;
        if (IN_PH()) {
            T_BEGIN();
            TID_LOCALS();
            if (!odd) {
                pg8::Gemm g{S3, Wb + W_QKV + (size_t)j * NQKV * D, M, NQKV, D}; pg8::StaticOrder S; S.init(M, NQKV, G, bx);
                pg8::EpiBf16R<1> E{S0, NQKV, SS + (size_t)((3 * i) & 1) * M * 16};
#ifndef NO_QKV
                pg8::gemm_phase<pg8::EpiBf16R<1>, pg8::StaticOrder, true, true>(lds, g, S, E);
#endif
            } else {
                pg8::Gemm g{S3, Wb + W_CIN + (size_t)j * NCIN * D, M, NCIN, D}; pg8::StaticOrder S; S.init(M, NCIN, G, bx);
                pg8::EpiBf16R<3> E{S0, 2048, SS + (size_t)((3 * i) & 1) * M * 16};
#ifndef NO_CIN
                pg8::gemm_phase<pg8::EpiBf16R<3>, pg8::StaticOrder, true, true>(lds, g, S, E);
#endif
            }
            T_END(1);
        }
        SEAM();
        if (IN_PH()) {
            T_BEGIN();
            TID_LOCALS();
            if (!odd) {
#pragma unroll 1
                for (int rep = 0; rep < ATTN_REPS; ++rep)
#ifndef NO_ATTN
                attn::attn_phase(lds, S0, S2, biasg, sink2 + j * 16, bx, G, 640 * 4);
#endif
            } else {
                const float* cw = conv_w + (size_t)j * 3 * D;
                const int c8 = (gt & 127) * 8;
                const f32x4 w0a = *(const f32x4*)(cw + c8), w0b = *(const f32x4*)(cw + c8 + 4), w1a = *(const f32x4*)(cw + D + c8), w1b = *(const f32x4*)(cw + D + c8 + 4),
                            w2a = *(const f32x4*)(cw + 2 * D + c8), w2b = *(const f32x4*)(cw + 2 * D + c8 + 4);
                constexpr int NCC = M * (D / 8);
                for (int c = gt; c < NCC; c += 2 * NGT) {
                    v4u bbv[2], zcv[2], zmv[2], zpv[2]; int rowv[2];
#pragma unroll
                    for (int q = 0; q < 2; ++q) {
                        const int cq = (c + q * NGT < NCC) ? c + q * NGT : c;
                        const int v = cq >> 7, gq = 4 - v / 16384, rem = v % 16384;
                        const int row = ((rem >> 11) * 40 + gq * 8) * 256 + (rem & 2047); rowv[q] = row;
                        const int pos = (row < MP) ? (row & (SEQ_P - 1)) : ((row - MP) & (SEQ_S - 1));
                        const int Sq = (row < MP) ? SEQ_P : SEQ_S;
                        const bf16* bz = S0 + (size_t)row * 2048;
                        bbv[q] = *(const v4u*)(bz + c8); zcv[q] = *(const v4u*)(bz + 1024 + c8);
                        zmv[q] = (v4u){0u, 0u, 0u, 0u}; zpv[q] = (v4u){0u, 0u, 0u, 0u};
                        if (pos > 0) zmv[q] = *(const v4u*)(bz - 2048 + 1024 + c8);
                        if (pos < Sq - 1) zpv[q] = *(const v4u*)(bz + 2048 + 1024 + c8);
                    }
#pragma unroll
                    for (int q = 0; q < 2; ++q) {
                        const v4u bb = bbv[q], zc = zcv[q], zm = zmv[q], zp = zpv[q];
                        float r[8];
#define CV(e, W0, W1, W2, ZM, ZC, ZP, BB, LOHI) r[e] = LOHI(BB) * (W0 * LOHI(ZM) + W1 * LOHI(ZC) + W2 * LOHI(ZP))
                        CV(0, w0a.x, w1a.x, w2a.x, zm.x, zc.x, zp.x, bb.x, pg8::bf_lo); CV(1, w0a.y, w1a.y, w2a.y, zm.x, zc.x, zp.x, bb.x, pg8::bf_hi);
                        CV(2, w0a.z, w1a.z, w2a.z, zm.y, zc.y, zp.y, bb.y, pg8::bf_lo); CV(3, w0a.w, w1a.w, w2a.w, zm.y, zc.y, zp.y, bb.y, pg8::bf_hi);
                        CV(4, w0b.x, w1b.x, w2b.x, zm.z, zc.z, zp.z, bb.z, pg8::bf_lo); CV(5, w0b.y, w1b.y, w2b.y, zm.z, zc.z, zp.z, bb.z, pg8::bf_hi);
                        CV(6, w0b.z, w1b.z, w2b.z, zm.w, zc.w, zp.w, bb.w, pg8::bf_lo); CV(7, w0b.w, w1b.w, w2b.w, zm.w, zc.w, zp.w, bb.w, pg8::bf_hi);
#undef CV
                        v4u w; w.x = pk2(r[0], r[1]); w.y = pk2(r[2], r[3]); w.z = pk2(r[4], r[5]); w.w = pk2(r[6], r[7]);
                        *(v4u*)(S2 + (size_t)rowv[q] * D + c8) = w;
                    }
                }
            }
            T_END((odd ? 5 : 2));
        }
        SEAM();
        if (IN_PH()) {
            T_BEGIN();
            pg8::Gemm g{S2, odd ? Wb + W_COUT + (size_t)j * D * D : Wb + W_O + (size_t)j * D * D, M, D, D}; pg8::StaticOrder S; S.init(M, D, G, bx);
            pg8::EpiResid<0> E{S3, XBm, SS + (size_t)((3 * i + 1) & 1) * M * 16, nullptr, nullptr};
#ifndef NO_MIXOUT
#ifndef MIX_REPS
#define MIX_REPS 1
#endif
#pragma unroll 1
            for (int rep = 0; rep < MIX_REPS; ++rep)
            pg8::gemm_phase<pg8::EpiResid<0>, pg8::StaticOrder, true, true>(lds, g, S, E);
#endif
            T_END(6);
        }
        SEAM();
        if (IN_PH()) {
            T_BEGIN();
            pg8::Gemm g{XBm, Wb + W_UP + (size_t)i * FF * D, M, FF, D}; pg8::StaticOrder S; S.init(M, FF, G, bx); S.reverse();
            pg8::EpiBf16R<2> E{S0, FF, SS + (size_t)((3 * i + 1) & 1) * M * 16};
#ifndef NO_UP
#pragma unroll 1
            for (int rep = 0; rep < UP_REPS; ++rep)
            pg8::gemm_phase<pg8::EpiBf16R<2>, pg8::StaticOrder, true, true>(lds, g, S, E);
#endif
            T_END(7);
        }
        SEAM();
        if (IN_PH()) {
            T_BEGIN();
            pg8::Gemm g{S0, Wb + W_DN + (size_t)i * D * FF, M, D, FF}; pg8::StaticOrder S; S.init(M, D, G, bx);
            pg8::EpiResid<2> E{XBm, XBm, SS + (size_t)((3 * i + 2) & 1) * M * 16, SS + (size_t)((3 * i + 1) & 1) * M * 16, nullptr};
#ifndef NO_DOWN
            pg8::gemm_phase<pg8::EpiResid<2>, pg8::StaticOrder, true, true>(lds, g, S, E);
#endif
            { TID_LOCALS();
            const float* pp = p_prompt + (size_t)i * MP * PLE; const float* ps = p_sample + (size_t)i * MS * PLE;
            constexpr int NCH = M * PLE / 8;
            for (int c = gt; c < NCH; c += 4 * NGT) {
                f32x4 a0[4], a1[4]; size_t eo[4];
#pragma unroll
                for (int q = 0; q < 4; ++q) {
                    const int cq = (c + q * NGT < NCH) ? c + q * NGT : c;
                    eo[q] = (size_t)cq * 8;
                    const float* src = (eo[q] < (size_t)MP * PLE) ? pp + eo[q] : ps + (eo[q] - (size_t)MP * PLE);
                    a0[q] = *(const f32x4*)src; a1[q] = *(const f32x4*)(src + 4);
                }
#pragma unroll
                for (int q = 0; q < 4; ++q) { v4u w; w.x = pk2(a0[q].x, a0[q].y); w.y = pk2(a0[q].z, a0[q].w); w.z = pk2(a1[q].x, a1[q].y); w.w = pk2(a1[q].z, a1[q].w); *(v4u*)(PB + eo[q]) = w; }
            }
            }
            T_END(8);
        }
        SEAM();
        if (IN_PH()) {
            T_BEGIN();
#ifndef PLE_REPS
#define PLE_REPS 1
#endif
#pragma unroll 1
            for (int rep = 0; rep < PLE_REPS; ++rep) {
            {
                pg8::Gemm g{PB, Wb + W_P + (size_t)i * D * PLE, M, D, PLE}; pg8::StaticOrder S; S.init(M, D, G, bx); S.reverse();
                pg8::EpiBf16R<0> E{S0, D, nullptr};
#ifndef NO_PROJ
                pg8::gemm_phase<pg8::EpiBf16R<0>, pg8::StaticOrder, true, true>(lds, g, S, E);
#endif
            }
            {
                pg8::Gemm g{XBm, Wb + W_G + (size_t)i * D * D, M, D, D}; pg8::StaticOrder S; S.init(M, D, G, bx); S.reverse();
                pg8::EpiResid<1> E{XBm, S3, SS + (size_t)((3 * i + 3) & 1) * M * 16, SS + (size_t)((3 * i + 2) & 1) * M * 16, S0};
#ifndef NO_GATE
                pg8::gemm_phase<pg8::EpiResid<1>, pg8::StaticOrder, true, true>(lds, g, S, E);
#endif
            }
            }
            T_END(9);
        }
        SEAM();
    }
    if (IN_PH()) {
        T_BEGIN();
        TID_LOCALS();
        const float* ssf = SS;
        for (int v0 = gw; v0 < M; v0 += 2 * NGW) {
            const int mm[2] = {row_of(v0, false), row_of((v0 + NGW < M) ? v0 + NGW : v0, false)};
            v2u xw[2][4]; pg8::f32x4 sv[2][4];
#pragma unroll
            for (int r = 0; r < 2; ++r) { const v2u* xb = (const v2u*)(S3 + (size_t)mm[r] * D) + lane; const pg8::f32x4* sp = (const pg8::f32x4*)(ssf + (size_t)mm[r] * 16);
#pragma unroll
                for (int q = 0; q < 4; ++q) { xw[r][q] = xb[64 * q]; sv[r][q] = sp[q]; } }
#pragma unroll
            for (int r = 0; r < 2; ++r) {
                const pg8::f32x4 s0 = sv[r][0], s1 = sv[r][1], s2 = sv[r][2], s3 = sv[r][3];
                const float rs = __builtin_amdgcn_rsqf(((((s0[0] + s0[1]) + (s0[2] + s0[3])) + ((s1[0] + s1[1]) + (s1[2] + s1[3]))) + (((s2[0] + s2[1]) + (s2[2] + s2[3])) + ((s3[0] + s3[1]) + (s3[2] + s3[3])))) * (1.0f / 1024.0f) + 1e-6f);
                f32x4* o4 = (f32x4*)(out + (size_t)mm[r] * D) + lane; const f32x4* g4 = (const f32x4*)final_norm + lane;
#pragma unroll
                for (int q = 0; q < 4; ++q) { const v2u w = xw[r][q]; const f32x4 gg = g4[64 * q]; f32x4 v; v.x = pg8::bf_lo(w.x); v.y = pg8::bf_hi(w.x); v.z = pg8::bf_lo(w.y); v.w = pg8::bf_hi(w.y); o4[64 * q] = v * rs * gg; }
            }
        }
        T_END(5);
    }
#if defined(PROBE_A)
    asm volatile("s_waitcnt vmcnt(0)" ::: "memory");
    if (blockIdx.x == 0 && threadIdx.x == 0 && hi == N_PHASES_C) { out[0] = (float)tA; out[1] = (float)tB; }
#endif
#undef IN_PH
#undef SEAM
}

constexpr int N_PHASES = 1 + 6 * DEPTH + 1;
extern "C" void kernel_launch(void* const* d_in, const int* in_sizes, int n_in, void* d_out, int out_size, void* d_ws, size_t ws_size, hipStream_t stream) {
    static int grid = 0;
    if (grid == 0) {
        if (n_in != 19 || out_size != M * D || ws_size < WS_END) { fprintf(stderr, "kernel_launch: unexpected shapes (n_in %d out %d ws %zu need %zu)\n", n_in, out_size, ws_size, (size_t)WS_END); grid = -1; return; }
        int dev = 0, cus = 0, per_cu = 0;
        hipGetDevice(&dev); hipDeviceGetAttribute(&cus, hipDeviceAttributeMultiprocessorCount, dev);
        if (hipFuncSetAttribute((const void*)fwd_kernel, hipFuncAttributeMaxDynamicSharedMemorySize, LDS_BYTES) != hipSuccess) { fprintf(stderr, "hipFuncSetAttribute failed\n"); grid = -1; return; }
        if (hipOccupancyMaxActiveBlocksPerMultiprocessor(&per_cu, (const void*)fwd_kernel, NWAVES * 64, LDS_BYTES) != hipSuccess || per_cu < 1) { fprintf(stderr, "occupancy query failed (%d)\n", per_cu); per_cu = 1; (void)hipGetLastError(); }
        grid = cus * per_cu;
    }
    if (grid < 0) return;
    if (hipMemsetAsync((char*)d_ws + WS_BAR, 0, WS_BAR_BYTES, stream) != hipSuccess) { fprintf(stderr, "memset failed\n"); return; }
    Args a{};
    for (int i = 0; i < 19; ++i) a.in[i] = (const float*)d_in[i];
    a.out = (float*)d_out; a.ws = (unsigned char*)d_ws;
#if defined(MK_MULTI)
    for (int p = 0; p < N_PHASES; ++p) { a.ph_lo = p; a.ph_hi = p + 1; hipLaunchKernelGGL(fwd_kernel, dim3(grid), dim3(NWAVES * 64), LDS_BYTES, stream, a); }
#else
    a.ph_lo = 0; a.ph_hi = N_PHASES;
    void* args[] = {&a};
    hipError_t e = hipLaunchCooperativeKernel((const void*)fwd_kernel, dim3(grid), dim3(NWAVES * 64), args, LDS_BYTES, stream);
    if (e != hipSuccess) fprintf(stderr, "cooperative launch failed: %s (grid %d)\n", hipGetErrorString(e), grid);
#endif
}
```
